# Optimizing an MI355X kernel written in HIP

```python
import math
import jax, jax.numpy as jnp
from jax import lax
import numpy as np


D_MODEL = 1024
BATCH = 8
SEQ = 4096
DEPTH = 2

GRID_W = 64
CTX_LEN = 256
N_MIXERS = 2
N_MLSTM_LAYERS = (DEPTH + N_MIXERS - 1) // N_MIXERS
N_SSD_LAYERS = DEPTH // N_MIXERS
N_MOD = 9
D_FF = 2816
CONV_W = 5
CHUNK = 128
EPS = 1e-6
ML_INNER = 2 * D_MODEL
ML_HEADS = 4
ML_HEAD_DIM = ML_INNER // ML_HEADS
ML_BLOCK = 4
ML_NBLOCKS = ML_INNER // ML_BLOCK
SSD_INNER = 2 * D_MODEL
SSD_HEAD_DIM = 64
SSD_HEADS = SSD_INNER // SSD_HEAD_DIM
SSD_GROUPS = 8
SSD_HPG = SSD_HEADS // SSD_GROUPS
SSD_STATE = 128
SSD_CONV_DIM = SSD_INNER + 2 * SSD_GROUPS * SSD_STATE
SSD_IN_DIM = SSD_INNER + SSD_CONV_DIM + 2 * SSD_HEADS

kernel_name = 'hybrid_mlstm_ssd_prefix_dit'


def rmsnorm(x, g):
    xf = x.astype(jnp.float32)
    y = xf * lax.rsqrt(jnp.mean(xf * xf, axis=-1, keepdims=True) + EPS)
    return (y * g.astype(jnp.float32)).astype(x.dtype)


def head_layernorm(h):
    mu = jnp.mean(h, axis=-1, keepdims=True)
    var = jnp.mean(jnp.square(h - mu), axis=-1, keepdims=True)
    return (h - mu) * lax.rsqrt(var + EPS)


def modulate(h, shift, scale):
    return h * (1.0 + scale) + shift


def short_conv(u, w, b, rows):
    bsz, t, ch = u.shape
    row_len = t // rows
    k = w.shape[0]
    pad = k // 2
    up = jnp.pad(u.reshape(bsz, rows, row_len, ch), ((0, 0), (0, 0), (pad, pad), (0, 0)))
    out = b
    for j in range(k):
        out = out + up[:, :, j:j + row_len] * w[j]
    return out.reshape(bsz, t, ch)


def to_chunks(t):
    bsz, tl = t.shape[:2]
    return jnp.moveaxis(t.reshape(bsz, tl // CHUNK, CHUNK, *t.shape[2:]), 1, 0)


def from_chunks(t):
    t = jnp.moveaxis(t, 0, 1)
    return t.reshape(t.shape[0], t.shape[1] * t.shape[2], *t.shape[3:])


def swiglu(h, w_gate, w_up, w_down):
    return (jax.nn.silu(h @ w_gate) * (h @ w_up)) @ w_down


def ffn_sub(x, mod, j0, g_pre, g_post, w_gate, w_up, w_down):
    h = modulate(rmsnorm(x, g_pre), mod[:, :, j0], mod[:, :, j0 + 1])
    return x + 0.5 * mod[:, :, j0 + 2] * rmsnorm(swiglu(h, w_gate, w_up, w_down), g_post)


def mlstm_scan(state, q, k, v, ig, lf):
    tril = jnp.tril(jnp.ones((CHUNK, CHUNK), bool))[None, :, :, None]

    def step(carry, inp):
        cmat, nvec, m = carry
        qc, kc, vc, igc, lfc = inp
        b = jnp.cumsum(lfc, axis=1)
        dm = b[:, :, None, :] - b[:, None, :, :] + igc[:, None, :, :]
        dm = jnp.where(tril, dm, -jnp.inf)
        m_inter = b + m[:, None, :]
        m_t = jnp.maximum(m_inter, jnp.max(dm, axis=2))
        s = jnp.einsum('bthd,bshd->btsh', qc, kc) * jnp.exp(dm - m_t[:, :, None, :])
        sc = jnp.exp(m_inter - m_t)
        num = jnp.einsum('btsh,bshv->bthv', s, vc) + sc[..., None] * jnp.einsum('bthd,bhdv->bthv', qc, cmat)
        den = jnp.sum(s, axis=2) + sc * jnp.einsum('bthd,bhd->bth', qc, nvec)
        h = num / jnp.maximum(jnp.abs(den), jnp.exp(-m_t))[..., None]
        b_end = b[:, -1]
        gl = b_end[:, None] - b + igc
        m_new = jnp.maximum(b_end + m, jnp.max(gl, axis=1))
        wgt = jnp.exp(gl - m_new[:, None])
        dec = jnp.exp(b_end + m - m_new)
        c_new = dec[..., None, None] * cmat + jnp.einsum('bsh,bshd,bshv->bhdv', wgt, kc, vc)
        n_new = dec[..., None] * nvec + jnp.einsum('bsh,bshd->bhd', wgt, kc)
        return (c_new, n_new, m_new), h

    state, h = lax.scan(step, state, tuple(to_chunks(t) for t in (q, k, v, ig, lf)))
    return from_chunks(h), state


def ssd_scan(state, xs, dt, la, bm, cm):
    tril = jnp.tril(jnp.ones((CHUNK, CHUNK), bool))[None, :, :, None, None]

    def step(h, inp):
        xc, dtc, lac, bc, cc = inp
        cs = jnp.cumsum(lac, axis=1)
        seg = cs[:, :, None] - cs[:, None, :]
        decay = jnp.exp(jnp.where(tril, seg, -jnp.inf))
        cb = jnp.einsum('btgn,bsgn->btsg', cc, bc)
        mmat = cb[..., None] * decay * dtc[:, None]
        y = jnp.einsum('btsgr,bsgrp->btgrp', mmat, xc) \
            + jnp.exp(cs)[..., None] * jnp.einsum('btgn,bgrpn->btgrp', cc, h)
        wgt = jnp.exp(cs[:, -1:] - cs) * dtc
        h_new = jnp.exp(cs[:, -1])[..., None, None] * h + jnp.einsum('bsgr,bsgrp,bsgn->bgrpn', wgt, xc, bc)
        return h_new, y

    state, y = lax.scan(step, state, tuple(to_chunks(t) for t in (xs, dt, la, bm, cm)))
    return from_chunks(y), state


def scan_both_ways(scan_fn, init_state, ctx_in, lat_in, reverse):
    if reverse:
        ctx_in = tuple(jnp.flip(t, axis=1) for t in ctx_in)
        lat_in = tuple(jnp.flip(t, axis=1) for t in lat_in)
    h_c, st = scan_fn(init_state, *ctx_in)
    h_l, _ = scan_fn(st, *lat_in)
    if reverse:
        h_c, h_l = jnp.flip(h_c, axis=1), jnp.flip(h_l, axis=1)
    return h_c, h_l


def mlstm_mixer(hc, hl, rows, need_ctx, w_in, conv_w, conv_b, w_q, w_k, w_v,
                w_gates, b_gates, norm_g, skip, w_out):
    def prep(h, n_rows):
        bsz, t, _ = h.shape
        xm, z = jnp.split(h @ w_in, 2, axis=-1)
        xc = jax.nn.silu(short_conv(xm, conv_w, conv_b, n_rows))

        def blk(u, w):
            return jnp.einsum('btnc,ncd->btnd', u.reshape(bsz, t, ML_NBLOCKS, ML_BLOCK), w).reshape(bsz, t, ML_INNER)

        q, k, v = blk(xc, w_q), blk(xc, w_k), blk(xm, w_v)
        gates = (q @ w_gates[:ML_INNER] + k @ w_gates[ML_INNER:2 * ML_INNER]
                 + v @ w_gates[2 * ML_INNER:] + b_gates)
        gates = gates.astype(jnp.float32).reshape(bsz, t, 2, 2, ML_HEADS)

        def heads(u):
            return u.astype(jnp.float32).reshape(bsz, t, ML_HEADS, ML_HEAD_DIM)

        return xc, z, heads(q), heads(k) * (ML_HEAD_DIM ** -0.5), heads(v), gates

    xc_c, z_c, qc, kc, vc, gc = prep(hc, 1)
    xc_l, z_l, ql, kl, vl, gl = prep(hl, rows)
    bsz = hl.shape[0]
    init = (jnp.zeros((bsz, ML_HEADS, ML_HEAD_DIM, ML_HEAD_DIM), jnp.float32),
            jnp.zeros((bsz, ML_HEADS, ML_HEAD_DIM), jnp.float32),
            jnp.zeros((bsz, ML_HEADS), jnp.float32))
    h_c, h_l = None, None
    for d in range(2):
        ctx_in = (qc, kc, vc, gc[:, :, d, 0], jax.nn.log_sigmoid(gc[:, :, d, 1]))
        lat_in = (ql, kl, vl, gl[:, :, d, 0], jax.nn.log_sigmoid(gl[:, :, d, 1]))
        hcd, hld = scan_both_ways(mlstm_scan, init, ctx_in, lat_in, reverse=(d == 1))
        h_c = hcd if d == 0 else h_c + hcd
        h_l = hld if d == 0 else h_l + hld

    def readout(h, xc, z):
        b_, t_ = h.shape[:2]
        h = head_layernorm(h).reshape(b_, t_, ML_INNER).astype(xc.dtype) * norm_g + skip * xc
        return (h * jax.nn.silu(z)) @ w_out

    y_l = readout(h_l, xc_l, z_l)
    y_c = readout(h_c, xc_c, z_c) if need_ctx else None
    return y_c, y_l


def ssd_mixer(hc, hl, rows, need_ctx, w_in, conv_w, conv_b, dt_bias, a_log, d_skip, norm_g, w_out):
    gn = SSD_GROUPS * SSD_STATE

    def prep(h, n_rows):
        bsz, t, _ = h.shape
        proj = h @ w_in
        z = proj[..., :SSD_INNER]
        xbc = jax.nn.silu(short_conv(proj[..., SSD_INNER:SSD_INNER + SSD_CONV_DIM], conv_w, conv_b, n_rows))
        xbc = xbc.astype(jnp.float32)
        xs = xbc[..., :SSD_INNER].reshape(bsz, t, SSD_GROUPS, SSD_HPG, SSD_HEAD_DIM)
        bm = xbc[..., SSD_INNER:SSD_INNER + gn].reshape(bsz, t, SSD_GROUPS, SSD_STATE)
        cm = xbc[..., SSD_INNER + gn:].reshape(bsz, t, SSD_GROUPS, SSD_STATE)
        dt_raw = proj[..., SSD_INNER + SSD_CONV_DIM:].astype(jnp.float32).reshape(bsz, t, 2, SSD_GROUPS, SSD_HPG)
        return z, xs, bm, cm, dt_raw

    z_c, xs_c, bm_c, cm_c, dt_c = prep(hc, 1)
    z_l, xs_l, bm_l, cm_l, dt_l = prep(hl, rows)
    bsz = hl.shape[0]
    init = jnp.zeros((bsz, SSD_GROUPS, SSD_HPG, SSD_HEAD_DIM, SSD_STATE), jnp.float32)
    y_c, y_l = None, None
    for d in range(2):
        a = -jnp.exp(a_log[d].astype(jnp.float32)).reshape(SSD_GROUPS, SSD_HPG)
        bias = dt_bias[d].astype(jnp.float32).reshape(SSD_GROUPS, SSD_HPG)
        dtc = jax.nn.softplus(dt_c[:, :, d] + bias)
        dtl = jax.nn.softplus(dt_l[:, :, d] + bias)
        ctx_in = (xs_c, dtc, dtc * a, bm_c, cm_c)
        lat_in = (xs_l, dtl, dtl * a, bm_l, cm_l)
        ycd, yld = scan_both_ways(ssd_scan, init, ctx_in, lat_in, reverse=(d == 1))
        y_c = ycd if d == 0 else y_c + ycd
        y_l = yld if d == 0 else y_l + yld
    dsk = d_skip.astype(jnp.float32).reshape(SSD_GROUPS, SSD_HPG)[..., None]

    def readout(y, xs, z):
        b_, t_ = y.shape[:2]
        y = (y + dsk * xs).reshape(b_, t_, SSD_INNER).astype(z.dtype)
        return rmsnorm(y * jax.nn.silu(z), norm_g) @ w_out

    out_l = readout(y_l, xs_l, z_l)
    out_c = readout(y_c, xs_c, z_c) if need_ctx else None
    return out_c, out_l


def setup_inputs(seed: int = 0) -> dict:
    key = jax.random.key(seed)
    ks = iter(jax.random.split(key, 40))
    f32 = jnp.float32

    def nrm(shape, s):
        return s * jax.random.normal(next(ks), shape, f32)

    nm, ns = N_MLSTM_LAYERS, N_SSD_LAYERS
    x = nrm((BATCH, SEQ, D_MODEL), 1.0)
    c = nrm((BATCH, D_MODEL), 1.0)
    ctx = nrm((BATCH, CTX_LEN, D_MODEL), 1.0)
    c_ctx = nrm((D_MODEL,), 1.0)
    ada_w = nrm((DEPTH, D_MODEL, N_MOD * D_MODEL), 0.5 * D_MODEL ** -0.5)
    ada_b = nrm((DEPTH, N_MOD * D_MODEL), 0.02)
    norm_g = 1.0 + nrm((DEPTH, 6, D_MODEL), 0.02)
    ffn_w_gate = nrm((DEPTH, 2, D_MODEL, D_FF), D_MODEL ** -0.5)
    ffn_w_up = nrm((DEPTH, 2, D_MODEL, D_FF), D_MODEL ** -0.5)
    ffn_w_down = nrm((DEPTH, 2, D_FF, D_MODEL), D_FF ** -0.5)
    mlstm_w_in = nrm((nm, D_MODEL, 2 * ML_INNER), D_MODEL ** -0.5)
    mlstm_conv_w = nrm((nm, CONV_W, ML_INNER), CONV_W ** -0.5)
    mlstm_conv_b = nrm((nm, ML_INNER), 0.02)
    mlstm_w_q = nrm((nm, ML_NBLOCKS, ML_BLOCK, ML_BLOCK), ML_BLOCK ** -0.5)
    mlstm_w_k = nrm((nm, ML_NBLOCKS, ML_BLOCK, ML_BLOCK), ML_BLOCK ** -0.5)
    mlstm_w_v = nrm((nm, ML_NBLOCKS, ML_BLOCK, ML_BLOCK), ML_BLOCK ** -0.5)
    mlstm_w_gates = nrm((nm, 3 * ML_INNER, 4 * ML_HEADS), 0.01)
    i_bias = nrm((nm, 2, 1, ML_HEADS), 0.1)
    f_bias = jnp.linspace(3.0, 6.0, ML_HEADS, dtype=f32) + nrm((nm, 2, 1, ML_HEADS), 0.1)
    mlstm_b_gates = jnp.concatenate([i_bias, f_bias], axis=2).reshape(nm, 4 * ML_HEADS)
    mlstm_norm_g = 1.0 + nrm((nm, ML_INNER), 0.02)
    mlstm_skip = 1.0 + nrm((nm, ML_INNER), 0.02)
    mlstm_w_out = nrm((nm, ML_INNER, D_MODEL), ML_INNER ** -0.5)
    ssd_w_in = nrm((ns, D_MODEL, SSD_IN_DIM), D_MODEL ** -0.5)
    ssd_conv_w = nrm((ns, CONV_W, SSD_CONV_DIM), CONV_W ** -0.5)
    ssd_conv_b = nrm((ns, SSD_CONV_DIM), 0.02)
    dt0 = jnp.exp(jax.random.uniform(next(ks), (ns, 2, SSD_HEADS), f32, math.log(1e-3), math.log(1e-1)))
    ssd_dt_bias = dt0 + jnp.log(-jnp.expm1(-dt0))
    ssd_a_log = jnp.log(jax.random.uniform(next(ks), (ns, 2, SSD_HEADS), f32, 1.0, 16.0))
    ssd_d = 1.0 + nrm((ns, SSD_HEADS), 0.1)
    ssd_norm_g = 1.0 + nrm((ns, SSD_INNER), 0.02)
    ssd_w_out = nrm((ns, SSD_INNER, D_MODEL), SSD_INNER ** -0.5)
    return {'x': x, 'c': c, 'ctx': ctx, 'c_ctx': c_ctx,
            'ada_w': ada_w, 'ada_b': ada_b, 'norm_g': norm_g,
            'ffn_w_gate': ffn_w_gate, 'ffn_w_up': ffn_w_up, 'ffn_w_down': ffn_w_down,
            'mlstm_w_in': mlstm_w_in, 'mlstm_conv_w': mlstm_conv_w, 'mlstm_conv_b': mlstm_conv_b,
            'mlstm_w_q': mlstm_w_q, 'mlstm_w_k': mlstm_w_k, 'mlstm_w_v': mlstm_w_v,
            'mlstm_w_gates': mlstm_w_gates, 'mlstm_b_gates': mlstm_b_gates,
            'mlstm_norm_g': mlstm_norm_g, 'mlstm_skip': mlstm_skip, 'mlstm_w_out': mlstm_w_out,
            'ssd_w_in': ssd_w_in, 'ssd_conv_w': ssd_conv_w, 'ssd_conv_b': ssd_conv_b,
            'ssd_dt_bias': ssd_dt_bias, 'ssd_a_log': ssd_a_log, 'ssd_d': ssd_d,
            'ssd_norm_g': ssd_norm_g, 'ssd_w_out': ssd_w_out}


def reference(x, c, ctx, c_ctx, ada_w, ada_b, norm_g, ffn_w_gate, ffn_w_up, ffn_w_down,
              mlstm_w_in, mlstm_conv_w, mlstm_conv_b, mlstm_w_q, mlstm_w_k, mlstm_w_v,
              mlstm_w_gates, mlstm_b_gates, mlstm_norm_g, mlstm_skip, mlstm_w_out,
              ssd_w_in, ssd_conv_w, ssd_conv_b, ssd_dt_bias, ssd_a_log, ssd_d,
              ssd_norm_g, ssd_w_out):
    bsz = x.shape[0]
    rows = x.shape[1] // GRID_W
    sc = jax.nn.silu(c)
    scc = jax.nn.silu(c_ctx)
    for i in range(DEPTH):
        last = i == DEPTH - 1
        mod_l = (sc @ ada_w[i] + ada_b[i]).reshape(bsz, 1, N_MOD, D_MODEL)
        mod_c = (scc @ ada_w[i] + ada_b[i]).reshape(1, 1, N_MOD, D_MODEL)
        g = norm_g[i]
        x = ffn_sub(x, mod_l, 0, g[0], g[1], ffn_w_gate[i, 0], ffn_w_up[i, 0], ffn_w_down[i, 0])
        ctx = ffn_sub(ctx, mod_c, 0, g[0], g[1], ffn_w_gate[i, 0], ffn_w_up[i, 0], ffn_w_down[i, 0])
        hl = modulate(rmsnorm(x, g[2]), mod_l[:, :, 3], mod_l[:, :, 4])
        hc = modulate(rmsnorm(ctx, g[2]), mod_c[:, :, 3], mod_c[:, :, 4])
        j = i // N_MIXERS
        if i % N_MIXERS == 0:
            yc, yl = mlstm_mixer(hc, hl, rows, not last, mlstm_w_in[j], mlstm_conv_w[j], mlstm_conv_b[j],
                                 mlstm_w_q[j], mlstm_w_k[j], mlstm_w_v[j], mlstm_w_gates[j],
                                 mlstm_b_gates[j], mlstm_norm_g[j], mlstm_skip[j], mlstm_w_out[j])
        else:
            yc, yl = ssd_mixer(hc, hl, rows, not last, ssd_w_in[j], ssd_conv_w[j], ssd_conv_b[j],
                               ssd_dt_bias[j], ssd_a_log[j], ssd_d[j], ssd_norm_g[j], ssd_w_out[j])
        x = x + mod_l[:, :, 5] * rmsnorm(yl, g[3])
        x = ffn_sub(x, mod_l, 6, g[4], g[5], ffn_w_gate[i, 1], ffn_w_up[i, 1], ffn_w_down[i, 1])
        if not last:
            ctx = ctx + mod_c[:, :, 5] * rmsnorm(yc, g[3])
            ctx = ffn_sub(ctx, mod_c, 6, g[4], g[5], ffn_w_gate[i, 1], ffn_w_up[i, 1], ffn_w_down[i, 1])
    return x
```

```cpp
#include <hip/hip_runtime.h>
#include <cstdio>
#include <cstdint>
#define XB_TMO      128
#define XB_XCNT(j)  (256  + 64 * (j))
#define XB_XSUB(j)  (1280 + 64 * (j))
#define XB_XGEN(j)  (2304 + 64 * (j))
#define XB_TOP      3328
#define XB_TOPGEN   3392
#define XCD_BAR_WORDS 3456
#define XB_SPIN_CAP (1u << 18)
#define LAS __attribute__((address_space(3)))

__device__ __forceinline__ unsigned xb_ld(unsigned* p)              { return __hip_atomic_load(p, __ATOMIC_RELAXED, __HIP_MEMORY_SCOPE_AGENT); }
__device__ __forceinline__ unsigned xb_add(unsigned* p, unsigned v) { return __hip_atomic_fetch_add(p, v, __ATOMIC_RELAXED, __HIP_MEMORY_SCOPE_AGENT); }
__device__ __forceinline__ unsigned xb_xcc_id() { return (unsigned)__builtin_amdgcn_s_getreg((3 << 11) | 20) & 0xFu; }
#define XB_SPIN(cond, bar) do { unsigned _sp = 0; while (cond) { __builtin_amdgcn_s_sleep(1); \
    if ((++_sp & 255u) == 0u) { if (xb_ld(&(bar)[XB_TMO])) break; if (_sp > XB_SPIN_CAP) { atomicAdd(&(bar)[XB_TMO], 1u); break; } } } } while (0)

struct XcdBarrier {
    unsigned* bar; unsigned x;
    volatile LAS unsigned* st;
};

__device__ __forceinline__ XcdBarrier xcd_barrier_post(unsigned* bar, volatile LAS unsigned* st) {
    XcdBarrier b; b.bar = bar; b.x = xb_xcc_id(); b.st = st;
    if (threadIdx.x == 0) (void)xb_add(&bar[XB_XCNT(b.x)], 1u);
    return b;
}
__device__ __forceinline__ void xcd_barrier_complete(unsigned* bar, unsigned x, unsigned& nloc, unsigned& nx) {
    const unsigned G = gridDim.x * gridDim.y * gridDim.z;
    unsigned sum, cnt, mine, sp = 0u;
    for (;;) {
        sum = 0u; cnt = 0u; mine = 0u;
#pragma unroll
        for (unsigned j = 0; j < 16; ++j) { const unsigned c = xb_ld(&bar[XB_XCNT(j)]); sum += c; cnt += (c > 0u) ? 1u : 0u; mine = (j == x) ? c : mine; }
        if (sum == G) break;
        __builtin_amdgcn_s_sleep(1);
        if ((++sp & 255u) == 0u) { if (xb_ld(&bar[XB_TMO])) break; if (sp > XB_SPIN_CAP) { atomicAdd(&bar[XB_TMO], 1u); break; } }
    }
    nloc = mine > 0u ? mine : 1u; nx = cnt > 0u ? cnt : 1u;
}

__device__ __forceinline__ void xcd_barrier(const XcdBarrier& b) {
    asm volatile("s_waitcnt vmcnt(0)" ::: "memory");
    __syncthreads();
    if (threadIdx.x == 0) {
        unsigned* bar = b.bar;
        __builtin_amdgcn_s_waitcnt(0);
        unsigned nloc = b.st[0], nx = b.st[1];
        if (nloc == 0u) { xcd_barrier_complete(bar, b.x, nloc, nx); b.st[0] = nloc; b.st[1] = nx; }
        const unsigned old = xb_add(&bar[XB_XSUB(b.x)], 1u);
        const unsigned gen = old / nloc;
        if (old + 1u == (gen + 1u) * nloc) {
            __builtin_amdgcn_fence(__ATOMIC_RELEASE, "agent");
            asm volatile("s_waitcnt vmcnt(0)" ::: "memory");
            const unsigned og = xb_add(&bar[XB_TOP], 1u);
            const unsigned tg = og / nx;
            if (og + 1u == (tg + 1u) * nx) xb_add(&bar[XB_TOPGEN], 1u);
            else XB_SPIN(xb_ld(&bar[XB_TOPGEN]) == tg, bar);
            __builtin_amdgcn_fence(__ATOMIC_ACQUIRE, "agent");
            xb_add(&bar[XB_XGEN(b.x)], 1u);
            asm volatile("s_waitcnt vmcnt(0)" ::: "memory");
        } else {
            XB_SPIN(xb_ld(&bar[XB_XGEN(b.x)]) == gen, bar);
            __builtin_amdgcn_fence(__ATOMIC_ACQUIRE, "agent");
            asm volatile("s_waitcnt vmcnt(0)" ::: "memory");
        }
    }
    __syncthreads();
}
namespace pg8 {
#define PG8_LAS __attribute__((address_space(3)))
typedef unsigned short bf16_t;
typedef short bf16x8 __attribute__((ext_vector_type(8)));
typedef float f32x4 __attribute__((ext_vector_type(4)));
typedef unsigned u32x4 __attribute__((ext_vector_type(4)));
constexpr int BM = 256, BK = 64, HALF = 128, HTB = HALF * BK * 2  , STAGE_BYTES = 8 * HTB, NXCD = 8, WGM = 8;

__host__ __device__ __forceinline__ int lds_byte(int r, int c) { const int st = (r >> 4) * 2 + (c >> 5), rr = r & 15, cc = c & 31, ob = rr * 64 + cc * 2; return st * 1024 + (ob ^ (((ob >> 9) & 1) << 5)); }
__host__ __device__ __forceinline__ void stage_rc(int b, int& R, int& C) { const int st = b / 1024, sb = b % 1024, swz = sb ^ (((sb >> 9) & 1) << 5); R = (st >> 1) * 16 + swz / 64; C = (st & 1) * 32 + (swz % 64) / 2; }
__host__ __device__ __forceinline__ int perm32(int rho) { const int n = rho >> 4, i = rho & 15; return 8 * (i >> 2) + 4 * n + (i & 3); }

struct Unit { int pm, pn; };
struct Gemm { const bf16_t* A; const bf16_t* Bt; int M, N, K; };

struct StaticOrder {
    int nM, nN, nwg, G, c;
    __host__ __device__ void init(int M, int N, int G_, int c_) { nM = M / BM; nN = N / BM; nwg = nM * nN; G = G_; c = c_; }
    __host__ __device__ bool next(int i, Unit& u) const {
        const long L = (long)i * G + c; if (L >= nwg) return false;
        int wgid = (int)L; { const int q = nwg / NXCD, r = nwg % NXCD, xcd = wgid % NXCD, off = wgid / NXCD; wgid = (xcd < r ? xcd * (q + 1) : r * (q + 1) + (xcd - r) * q) + off; }
        const int nig = WGM * nN, gid = wgid / nig, fm = gid * WGM, gsz = (nM - fm) < WGM ? (nM - fm) : WGM;
        u.pm = fm + ((wgid % nig) % gsz); u.pn = (wgid % nig) / gsz; return true;
    }
    __device__ __forceinline__ void a_ready(const Unit&) const {}
    __device__ __forceinline__ void done(const Unit&) const {}
};
__device__ __forceinline__ unsigned cvt_pk_bf16(float lo, float hi) { unsigned r; asm volatile("v_cvt_pk_bf16_f32 %0, %1, %2" : "=v"(r) : "v"(lo), "v"(hi)); return r; }
typedef float f32x2 __attribute__((ext_vector_type(2)));
__device__ __forceinline__ f32x2 gelu_pk(f32x2 v) {
    const f32x2 av = __builtin_elementwise_abs(v), d = av * 0.2316418882f + 1.0f;
    f32x2 t; t.x = __builtin_amdgcn_rcpf(d.x); t.y = __builtin_amdgcn_rcpf(d.y);
    f32x2 q = t * 0.5307027145f + (-0.7265760135f); q = q * t + 0.7107068705f; q = q * t + (-0.142248368f); q = q * t + 0.127414796f; q = q * t;
    const f32x2 s = (v * v) * (-0.72134752044f);
    f32x2 e; e.x = __builtin_amdgcn_exp2f(s.x); e.y = __builtin_amdgcn_exp2f(s.y);
    const f32x2 m = v * (q * e), r = v - m;
    f32x2 o; o.x = v.x < 0.f ? m.x : r.x; o.y = v.y < 0.f ? m.y : r.y; return o;
}

struct EpiF32 {
    static constexpr bool PERM = false, AFTER_DRAIN = false;
    float* C; int ldc; const float* bias;
    __device__ __forceinline__ void operator()(const f32x4 (&acc)[2][2][4][2], const Unit& u, int wr, int wc, int fr, int fq) const {
        const int row0 = u.pm * BM + wr * 64 + fr, col0 = u.pn * BM + wc * 32 + 4 * fq;
        f32x4 bv[2][2];
#pragma unroll
        for (int bj = 0; bj < 2; ++bj)
#pragma unroll
            for (int n = 0; n < 2; ++n) bv[bj][n] = bias ? *(const f32x4*)(bias + col0 + bj * HALF + n * 16) : (f32x4){0.f, 0.f, 0.f, 0.f};
#pragma unroll
        for (int ai = 0; ai < 2; ++ai)
#pragma unroll
            for (int m = 0; m < 4; ++m) { float* rowp = C + (size_t)(row0 + ai * HALF + m * 16) * ldc + col0;
#pragma unroll
                for (int bj = 0; bj < 2; ++bj)
#pragma unroll
                    for (int n = 0; n < 2; ++n) *(f32x4*)(rowp + bj * HALF + n * 16) = acc[ai][bj][m][n] + bv[bj][n]; }
    }
};
template <int ACT  > struct EpiBf16 {
    static constexpr bool PERM = true, AFTER_DRAIN = false;
    bf16_t* O; int ldc; const float* bias; int split_cols; size_t split_stride;
    __device__ __forceinline__ void operator()(const f32x4 (&acc)[2][2][4][2], const Unit& u, int wr, int wc, int fr, int fq) const {
        const int row0 = u.pm * BM + wr * 64 + fr; int colt = u.pn * BM; bf16_t* base = O;
        if (split_cols) { const int t = colt / split_cols; base += (size_t)t * split_stride; colt -= t * split_cols; }
        const int col0 = colt + wc * 32 + 8 * fq, bcol0 = u.pn * BM + wc * 32 + 8 * fq;
        f32x4 bv[2][2];
#pragma unroll
        for (int bj = 0; bj < 2; ++bj)
#pragma unroll
            for (int n = 0; n < 2; ++n) bv[bj][n] = bias ? *(const f32x4*)(bias + bcol0 + bj * HALF + 4 * n) : (f32x4){0.f, 0.f, 0.f, 0.f};
#pragma unroll
        for (int ai = 0; ai < 2; ++ai)
#pragma unroll
            for (int m = 0; m < 4; ++m) { bf16_t* rowp = base + (size_t)(row0 + ai * HALF + m * 16) * ldc + col0;
#pragma unroll
                for (int bj = 0; bj < 2; ++bj) { f32x4 v0 = acc[ai][bj][m][0] + bv[bj][0], v1 = acc[ai][bj][m][1] + bv[bj][1];
                    if (ACT == 1) { f32x2 a = gelu_pk((f32x2){v0[0], v0[1]}), b = gelu_pk((f32x2){v0[2], v0[3]}), c = gelu_pk((f32x2){v1[0], v1[1]}), d = gelu_pk((f32x2){v1[2], v1[3]});
                        v0 = (f32x4){a.x, a.y, b.x, b.y}; v1 = (f32x4){c.x, c.y, d.x, d.y}; }
                    if (ACT == 2) {
#pragma unroll
                        for (int j = 0; j < 4; ++j) { v0[j] = 0.5f * v0[j] * (1.0f + erff(v0[j] * 0.70710678f)); v1[j] = 0.5f * v1[j] * (1.0f + erff(v1[j] * 0.70710678f)); } }
                    u32x4 w; w.x = cvt_pk_bf16(v0[0], v0[1]); w.y = cvt_pk_bf16(v0[2], v0[3]); w.z = cvt_pk_bf16(v1[0], v1[1]); w.w = cvt_pk_bf16(v1[2], v1[3]);
                    *(u32x4*)(rowp + bj * HALF) = w; } }
    }
};

template <class Epi, class Sched, bool STAMP = false>
__device__ __forceinline__ void gemm_phase(PG8_LAS unsigned char* lds, const Gemm g, const Sched& S, const Epi& E, unsigned long long* stamps) {
    int tid_raw = threadIdx.x; asm volatile("" : "+v"(tid_raw));
    const int tid = tid_raw, wid = __builtin_amdgcn_readfirstlane(tid >> 6), lane = tid & 63, wr = wid >> 2, wc = wid & 3, fr = lane & 15, fq = lane >> 4;
    const int K = g.K, nt = K / BK;
    int ts_lo = 0, ts_hi = 0, nts = 0; const unsigned long long rt_entry = STAMP ? (unsigned long long)wall_clock64() : 0ull;
#define PG8_STAMP() do { if (STAMP && wid == 0 && nts < 64) { const unsigned long long _c = (unsigned long long)clock64(); \
        ts_lo = (lane == nts) ? (int)(unsigned)_c : ts_lo; ts_hi = (lane == nts) ? (int)(unsigned)(_c >> 32) : ts_hi; ++nts; } } while (0)
    PG8_STAMP();
    unsigned voffA[2], voffB[2];
#pragma unroll
    for (int i = 0; i < 2; ++i) { int R, C; stage_rc(tid * 16 + i * 8192, R, C); const int Rb = Epi::PERM ? ((R & ~31) + perm32(R & 31)) : R;
        voffA[i] = (unsigned)(R * K + C) * 2u; voffB[i] = (unsigned)(Rb * K + C) * 2u; }
    const size_t kstep = (size_t)(BK * 2);
    const size_t hstep = (size_t)HALF * K * 2;
    const size_t tstep = 2 * hstep;
    const unsigned ldsw = (unsigned)wid * 1024u;
    const int aoff = lds_byte(wr * 64 + fr, fq * 8), boff = lds_byte(wc * 32 + fr, fq * 8);
#define PG8_SA(b, h) (((b) * 2 + (h)) * HTB)
#define PG8_SB(b, h) ((4 + (b) * 2 + (h)) * HTB)
#define PG8_STAGE(bufoff, gbase, voff) do { _Pragma("unroll") for (int _i = 0; _i < 2; ++_i) \
        __builtin_amdgcn_global_load_lds((const unsigned*)((const char*)(gbase) + (voff)[_i]), (PG8_LAS unsigned*)(lds + (bufoff) + ldsw + _i * 8192), 16, 0, 0); } while (0)
#define PG8_LDA(dst, b, h) do { _Pragma("unroll") for (int m = 0; m < 4; ++m) _Pragma("unroll") for (int k = 0; k < 2; ++k) dst[m][k] = *(const PG8_LAS bf16x8*)(lds + PG8_SA(b, h) + aoff + m * 2048 + k * 1024); } while (0)
#define PG8_LDB(dst, b, h) do { _Pragma("unroll") for (int n = 0; n < 2; ++n) _Pragma("unroll") for (int k = 0; k < 2; ++k) dst[n][k] = *(const PG8_LAS bf16x8*)(lds + PG8_SB(b, h) + boff + n * 2048 + k * 1024); } while (0)
#define PG8_MMA(ai, bj, At, Bt) do { __builtin_amdgcn_s_setprio(1); _Pragma("unroll") for (int m = 0; m < 4; ++m) _Pragma("unroll") for (int n = 0; n < 2; ++n) _Pragma("unroll") for (int k = 0; k < 2; ++k) \
        acc[ai][bj][m][n] = __builtin_amdgcn_mfma_f32_16x16x32_bf16(Bt[n][k], At[m][k], acc[ai][bj][m][n], 0, 0, 0); __builtin_amdgcn_s_setprio(0); } while (0)
#define PG8_WAIT_V(n) asm volatile("s_waitcnt vmcnt(" #n ")" ::: "memory")
#define PG8_WAIT_L(n) asm volatile("s_waitcnt lgkmcnt(" #n ")" ::: "memory")
#define PG8_BAR __builtin_amdgcn_s_barrier()
#define PG8_SCHED __builtin_amdgcn_sched_barrier(0)
    Unit cur, nxt; int ui = 0;
    if (!S.next(0, cur)) return;
    f32x4 acc[2][2][4][2];
#pragma unroll
    for (int a = 0; a < 2; ++a)
#pragma unroll
        for (int b = 0; b < 2; ++b)
#pragma unroll
            for (int m = 0; m < 4; ++m)
#pragma unroll
                for (int n = 0; n < 2; ++n) acc[a][b][m][n] = (f32x4){0.f, 0.f, 0.f, 0.f};
    bf16x8 At[4][2], B0[2][2], B1[2][2];
    const char* cA = (const char*)g.A + (size_t)cur.pm * tstep; const char* cB = (const char*)g.Bt + (size_t)cur.pn * tstep;
    S.a_ready(cur);
    PG8_STAGE(PG8_SB(0, 0), cB, voffB); PG8_STAGE(PG8_SA(0, 0), cA, voffA); PG8_STAGE(PG8_SB(0, 1), cB + hstep, voffB); PG8_STAGE(PG8_SA(0, 1), cA + hstep, voffA);
    if (wr == 1) PG8_BAR;
    PG8_WAIT_V(4); PG8_BAR;
    PG8_STAGE(PG8_SB(1, 0), cB + kstep, voffB); PG8_STAGE(PG8_SA(1, 0), cA + kstep, voffA); PG8_STAGE(PG8_SB(1, 1), cB + hstep + kstep, voffB);
    PG8_WAIT_V(6); PG8_BAR;
    PG8_STAMP();
    for (;;) {
        const bool has_next = S.next(ui + 1, nxt);
        const char* nA = has_next ? (const char*)g.A + (size_t)nxt.pm * tstep : cA; const char* nB = has_next ? (const char*)g.Bt + (size_t)nxt.pn * tstep : cB;
        for (int t = 0; t < nt; t += 2) {
            const bool last = (t == nt - 2);
            const char* a1 = cA + (size_t)(t + 1) * kstep;
            const char* a2 = last ? nA : cA + (size_t)(t + 2) * kstep; const char* b2 = last ? nB : cB + (size_t)(t + 2) * kstep;
            const char* a3 = a2 + kstep; const char* b3 = b2 + kstep;
            if (last && has_next) S.a_ready(nxt);
            PG8_LDB(B0, 0, 0); PG8_SCHED; PG8_LDA(At, 0, 0); PG8_STAGE(PG8_SA(1, 1), a1 + hstep, voffA);
            PG8_WAIT_L(8); PG8_BAR; PG8_WAIT_L(0); PG8_MMA(0, 0, At, B0); PG8_BAR; PG8_SCHED;
            PG8_LDB(B1, 0, 1); PG8_STAGE(PG8_SB(0, 0), b2, voffB);
            PG8_BAR; PG8_WAIT_L(0); PG8_MMA(0, 1, At, B1); PG8_BAR;
            PG8_LDA(At, 0, 1); PG8_STAGE(PG8_SA(0, 0), a2, voffA);
            PG8_BAR; PG8_WAIT_L(0); PG8_MMA(1, 0, At, B0); PG8_BAR; PG8_SCHED;
            PG8_STAGE(PG8_SB(0, 1), b2 + hstep, voffB);
            PG8_WAIT_V(6); PG8_BAR; PG8_MMA(1, 1, At, B1); PG8_BAR;
            PG8_LDB(B0, 1, 0); PG8_SCHED; PG8_LDA(At, 1, 0); PG8_STAGE(PG8_SA(0, 1), a2 + hstep, voffA);
            PG8_WAIT_L(8); PG8_BAR; PG8_WAIT_L(0); PG8_MMA(0, 0, At, B0); PG8_BAR; PG8_SCHED;
            PG8_LDB(B1, 1, 1); PG8_STAGE(PG8_SB(1, 0), b3, voffB);
            PG8_BAR; PG8_WAIT_L(0); PG8_MMA(0, 1, At, B1); PG8_BAR;
            PG8_LDA(At, 1, 1); PG8_STAGE(PG8_SA(1, 0), a3, voffA);
            PG8_BAR; PG8_WAIT_L(0); PG8_MMA(1, 0, At, B0); PG8_BAR; PG8_SCHED;
            PG8_STAGE(PG8_SB(1, 1), b3 + hstep, voffB);
            PG8_WAIT_V(6); PG8_BAR; PG8_MMA(1, 1, At, B1); PG8_BAR;
        }
        PG8_STAMP();
        if constexpr (!Epi::AFTER_DRAIN) { E(acc, cur, wr, wc, fr, fq); S.done(cur); }
        PG8_STAMP();
        if (!has_next) break;
#pragma unroll
        for (int a = 0; a < 2; ++a)
#pragma unroll
            for (int b = 0; b < 2; ++b)
#pragma unroll
                for (int m = 0; m < 4; ++m)
#pragma unroll
                    for (int n = 0; n < 2; ++n) acc[a][b][m][n] = (f32x4){0.f, 0.f, 0.f, 0.f};
        cur = nxt; cA = nA; cB = nB; ++ui;
    }
    PG8_WAIT_V(0);
    if (wr == 0) PG8_BAR;
    PG8_BAR;
    if constexpr (Epi::AFTER_DRAIN) { E.fused(acc, cur, wr, wc, fr, fq, lds, wid, lane); S.done(cur); }
    PG8_STAMP();
    if (STAMP && wid == 0) { stamps[lane] = lane < nts ? (((unsigned long long)(unsigned)ts_hi << 32) | (unsigned)ts_lo) : 0ull;
        if (lane == 62) stamps[62] = rt_entry; if (lane == 63) stamps[63] = (unsigned long long)wall_clock64(); }
#undef PG8_STAMP
#undef PG8_SA
#undef PG8_SB
#undef PG8_STAGE
#undef PG8_LDA
#undef PG8_LDB
#undef PG8_MMA
#undef PG8_WAIT_V
#undef PG8_WAIT_L
#undef PG8_BAR
#undef PG8_SCHED
}
}
namespace mk {
using pg8::bf16_t; using pg8::bf16x8; using pg8::f32x4; using pg8::u32x4; using pg8::cvt_pk_bf16;
typedef unsigned u32x2 __attribute__((ext_vector_type(2)));
typedef LAS unsigned char* ldsp;

constexpr int DM = 1024, NB = 8, SEQ = 4096, CTX = 256, TB = SEQ + CTX, T = NB * TB, HT = T / 2, DFF = 2816, INNER = 2048;
constexpr int CH = 128, NCH = TB / CH;
constexpr int NWAVES = 8, NTH = 512;
constexpr float EPS = 1e-6f;
constexpr size_t MiB = 1u << 20;
constexpr size_t WS_CTL = 0, CTL_ZERO_BYTES = 128 * 1024;
constexpr size_t WS_MOD = 1 * MiB;
constexpr size_t WS_WG = 1 * MiB + 768 * 1024;
constexpr size_t WS_GATES = 2 * MiB;
constexpr size_t WS_DT = 3 * MiB + 512 * 1024;
constexpr size_t WS_W = 8 * MiB;
constexpr size_t WS_CTXS = 58 * MiB;
constexpr size_t WS_H = 66 * MiB;
constexpr size_t WS_Y = 134 * MiB;
constexpr size_t WS_BIG = 202 * MiB;
constexpr size_t SLOT = 68 * MiB;
constexpr size_t WS_END = 474 * MiB;
constexpr size_t WO_GU1 = 0, WO_D1 = WO_GU1 + (size_t)2 * DFF * DM, WO_IN = WO_D1 + (size_t)DM * DFF, WO_OUT = WO_IN + (size_t)6400 * DM,
                 WO_GU2 = WO_OUT + (size_t)DM * INNER, WO_D2 = WO_GU2 + (size_t)2 * DFF * DM, WO_END = WO_D2 + (size_t)DM * DFF;
static_assert(WS_W + WO_END * 2 <= WS_CTXS && WS_BIG + 4 * SLOT == WS_END && (size_t)HT * INNER * 2 == SLOT && (size_t)T * DFF * 2 <= 4 * SLOT, "d_ws map");
static_assert(WS_GATES + (size_t)HT * 16 * 4 <= WS_DT && WS_DT + (size_t)HT * 64 * 4 <= WS_W && WS_MOD + 2 * 9 * 9216 * 4 <= WS_WG && WS_WG + 16 * 6144 * 2 <= WS_GATES, "d_ws map small");
constexpr int LDS_BYTES = 155648;
constexpr int LDS_XB = LDS_BYTES - 16;

__device__ __forceinline__ float bflo(unsigned w) { return __uint_as_float(w << 16); }
__device__ __forceinline__ float bfhi(unsigned w) { return __uint_as_float(w & 0xffff0000u); }
__device__ __forceinline__ float bf1(unsigned short h) { return __uint_as_float(((unsigned)h) << 16); }
__device__ __forceinline__ unsigned short f2bf(float f) { return (unsigned short)(cvt_pk_bf16(f, 0.f) & 0xffffu); }
__device__ __forceinline__ float silu_f(float x) { return x * __builtin_amdgcn_rcpf(1.f + __expf(-x)); }
__device__ __forceinline__ float softplus_f(float x) { return fmaxf(x, 0.f) + log1pf(__expf(-fabsf(x))); }
__device__ __forceinline__ float wave_sum(float v) {
#pragma unroll
    for (int o = 1; o < 64; o <<= 1) v += __shfl_xor(v, o);
    return v;
}
__device__ __forceinline__ void unpack8(const u32x4 w, float (&f)[8]) {
    f[0] = bflo(w.x); f[1] = bfhi(w.x); f[2] = bflo(w.y); f[3] = bfhi(w.y); f[4] = bflo(w.z); f[5] = bfhi(w.z); f[6] = bflo(w.w); f[7] = bfhi(w.w);
}
__device__ __forceinline__ u32x4 pack8(const float (&f)[8]) {
    u32x4 w; w.x = cvt_pk_bf16(f[0], f[1]); w.y = cvt_pk_bf16(f[2], f[3]); w.z = cvt_pk_bf16(f[4], f[5]); w.w = cvt_pk_bf16(f[6], f[7]); return w;
}
template <int MI, int NI, int KS>
__device__ __forceinline__ void wmma(f32x4 (&acc)[MI][NI], const LAS bf16_t* A, int lda, const LAS bf16_t* B, int ldb, int lane) {
    const int r = lane & 15, kq = lane >> 4;
#pragma unroll
    for (int ks = 0; ks < KS; ++ks) {
        bf16x8 a[MI], b[NI];
#pragma unroll
        for (int mi = 0; mi < MI; ++mi) a[mi] = *(const LAS bf16x8*)(A + (mi * 16 + r) * lda + ks * 32 + kq * 8);
#pragma unroll
        for (int ni = 0; ni < NI; ++ni) b[ni] = *(const LAS bf16x8*)(B + (ni * 16 + r) * ldb + ks * 32 + kq * 8);
#pragma unroll
        for (int mi = 0; mi < MI; ++mi)
#pragma unroll
            for (int ni = 0; ni < NI; ++ni) acc[mi][ni] = __builtin_amdgcn_mfma_f32_16x16x32_bf16(a[mi], b[ni], acc[mi][ni], 0, 0, 0);
    }
}

struct Args { const float* in[29]; float* out; unsigned char* ws; int ph_lo, ph_hi; };

struct EpiSwiglu {
    static constexpr bool PERM = true, AFTER_DRAIN = false;
    bf16_t* O; int ldc;
    __device__ __forceinline__ void operator()(const f32x4 (&acc)[2][2][4][2], const pg8::Unit& u, int wr, int wc, int fr, int fq) const {
        const int row0 = u.pm * 256 + wr * 64 + fr, col0 = u.pn * 128 + wc * 32 + 8 * fq;
#pragma unroll
        for (int ai = 0; ai < 2; ++ai)
#pragma unroll
            for (int m = 0; m < 4; ++m) {
                float v[8];
#pragma unroll
                for (int n = 0; n < 2; ++n)
#pragma unroll
                    for (int j = 0; j < 4; ++j) v[n * 4 + j] = silu_f(acc[ai][0][m][n][j]) * acc[ai][1][m][n][j];
                *(u32x4*)(O + (size_t)(row0 + ai * 128 + m * 16) * ldc + col0) = pack8(v);
            }
    }
};
template <bool TWO> struct EpiMulSilu {
    static constexpr bool PERM = true, AFTER_DRAIN = false;
    bf16_t* R; const bf16_t* R2; int ldc;
    __device__ __forceinline__ void operator()(const f32x4 (&acc)[2][2][4][2], const pg8::Unit& u, int wr, int wc, int fr, int fq) const {
        const int row0 = u.pm * 256 + wr * 64 + fr, col0 = u.pn * 256 + wc * 32 + 8 * fq;
#pragma unroll
        for (int ai = 0; ai < 2; ++ai)
#pragma unroll
            for (int m = 0; m < 4; ++m)
#pragma unroll
                for (int bj = 0; bj < 2; ++bj) {
                    const size_t o = (size_t)(row0 + ai * 128 + m * 16) * ldc + col0 + bj * 128;
                    float r[8]; unpack8(*(const u32x4*)(R + o), r);
                    if (TWO) { float r2[8]; unpack8(*(const u32x4*)(R2 + o), r2);
#pragma unroll
                        for (int j = 0; j < 8; ++j) r[j] += r2[j]; }
#pragma unroll
                    for (int n = 0; n < 2; ++n)
#pragma unroll
                        for (int j = 0; j < 4; ++j) r[n * 4 + j] *= silu_f(acc[ai][bj][m][n][j]);
                    *(u32x4*)(R + o) = pack8(r);
                }
    }
};
struct EpiSsdIn {
    static constexpr bool PERM = true, AFTER_DRAIN = false;
    bf16_t* X; float* DT;
    __device__ __forceinline__ void operator()(const f32x4 (&acc)[2][2][4][2], const pg8::Unit& u, int wr, int wc, int fr, int fq) const {
        const int row0 = u.pm * 256 + wr * 64 + fr;
        if (u.pn < 16) {
            const int col0 = u.pn * 256 + wc * 32 + 8 * fq;
#pragma unroll
            for (int ai = 0; ai < 2; ++ai)
#pragma unroll
                for (int m = 0; m < 4; ++m)
#pragma unroll
                    for (int bj = 0; bj < 2; ++bj) {
                        u32x4 w; const f32x4 v0 = acc[ai][bj][m][0], v1 = acc[ai][bj][m][1];
                        w.x = cvt_pk_bf16(v0[0], v0[1]); w.y = cvt_pk_bf16(v0[2], v0[3]); w.z = cvt_pk_bf16(v1[0], v1[1]); w.w = cvt_pk_bf16(v1[2], v1[3]);
                        *(u32x4*)(X + (size_t)(row0 + ai * 128 + m * 16) * 4096 + col0 + bj * 128) = w;
                    }
        } else if (wc < 2) {
            const int col0 = wc * 32 + 8 * fq;
#pragma unroll
            for (int ai = 0; ai < 2; ++ai)
#pragma unroll
                for (int m = 0; m < 4; ++m) {
                    float* p = DT + (size_t)(row0 + ai * 128 + m * 16) * 64 + col0;
                    *(f32x4*)p = acc[ai][0][m][0]; *(f32x4*)(p + 4) = acc[ai][0][m][1];
                }
        }
    }
};

__device__ __forceinline__ void tr_item(const float* W, int ldw, int K, bf16_t* WT, int k0, int n0, int drow0, LAS float* scr, int lane) {
#pragma unroll 8
    for (int i = 0; i < 32; ++i) { const int kk = 2 * i + (lane >> 5); scr[kk * 33 + (lane & 31)] = W[(size_t)(k0 + kk) * ldw + n0 + (lane & 31)]; }
    asm volatile("s_waitcnt lgkmcnt(0)" ::: "memory");
    const int c = lane & 7;
#pragma unroll
    for (int j = 0; j < 4; ++j) { const int n = (lane >> 3) + 8 * j; const LAS float* s = scr + (8 * c) * 33 + n;
        u32x4 o; o.x = cvt_pk_bf16(s[0 * 33], s[1 * 33]); o.y = cvt_pk_bf16(s[2 * 33], s[3 * 33]); o.z = cvt_pk_bf16(s[4 * 33], s[5 * 33]); o.w = cvt_pk_bf16(s[6 * 33], s[7 * 33]);
        *(u32x4*)(WT + (size_t)(drow0 + n) * K + k0 + 8 * c) = o; }
    asm volatile("s_waitcnt lgkmcnt(0)" ::: "memory");
}
__device__ __forceinline__ void convert_layer(const Args& a, int layer, ldsp lds, int gw, int NGW, int wave, int lane) {
    LAS float* scr = (LAS float*)(lds + wave * 16384);
    bf16_t* W = (bf16_t*)(a.ws + WS_W);
    const float* wg0 = a.in[7] + (size_t)(layer * 2 + 0) * DM * DFF; const float* wu0 = a.in[8] + (size_t)(layer * 2 + 0) * DM * DFF; const float* wd0 = a.in[9] + (size_t)(layer * 2 + 0) * DFF * DM;
    const float* wg1 = a.in[7] + (size_t)(layer * 2 + 1) * DM * DFF; const float* wu1 = a.in[8] + (size_t)(layer * 2 + 1) * DM * DFF; const float* wd1 = a.in[9] + (size_t)(layer * 2 + 1) * DFF * DM;
    const float* win = layer == 0 ? a.in[10] : a.in[21]; const int nin = layer == 0 ? 4096 : 6208;
    const float* wout = layer == 0 ? a.in[20] : a.in[28];
    const int total = 4 * 16 * 88 + 2 * 44 * 32 + 16 * (nin / 32) + 32 * 32;
#define MK_TRJOB(src, ldw, K, N, dst, mode) { const int nb_ = (N) / 32, ni_ = ((K) / 64) * nb_; if (r >= 0 && r < ni_) { const int kb_ = r / nb_, n0_ = (r % nb_) * 32; \
        const int d0_ = (mode) == 0 ? n0_ : 256 * (n0_ / 128) + (n0_ % 128) + ((mode) == 2 ? 128 : 0); tr_item(src, ldw, K, dst, kb_ * 64, n0_, d0_, scr, lane); } r -= ni_; }
    for (int it = gw; it < total; it += NGW) {
        int r = it;
        MK_TRJOB(wg0, DFF, DM, DFF, W + WO_GU1, 1)
        MK_TRJOB(wu0, DFF, DM, DFF, W + WO_GU1, 2)
        MK_TRJOB(wg1, DFF, DM, DFF, W + WO_GU2, 1)
        MK_TRJOB(wu1, DFF, DM, DFF, W + WO_GU2, 2)
        MK_TRJOB(wd0, DM, DFF, DM, W + WO_D1, 0)
        MK_TRJOB(wd1, DM, DFF, DM, W + WO_D2, 0)
        MK_TRJOB(win, nin, DM, nin, W + WO_IN, 0)
        MK_TRJOB(wout, DM, INNER, DM, W + WO_OUT, 0)
    }
#undef MK_TRJOB
    if (layer == 1) {
        u32x4* z = (u32x4*)(W + WO_IN + (size_t)6208 * DM);
        for (int i = gw * 64 + lane; i < 192 * DM / 8; i += NGW * 64) z[i] = (u32x4){0u, 0u, 0u, 0u};
    }
}
__device__ __forceinline__ void mods_phase(const Args& a, ldsp lds, int blk, int G, int tid) {
    LAS float* sv = (LAS float*)lds;
    LAS float* red = (LAS float*)(lds + 40960);
    float* mod = (float*)(a.ws + WS_MOD);
    for (int i = tid; i < 9 * DM; i += NTH) { const int v = i >> 10, k = i & 1023; sv[i] = silu_f(v < 8 ? a.in[1][v * DM + k] : a.in[3][k]); }
    __syncthreads();
    const int col = tid & 63, ks = tid >> 6;
    for (int u = blk; u < 2 * 144; u += G) {
        const int layer = u / 144, n0 = (u % 144) * 64;
        const float* W = a.in[4] + (size_t)layer * DM * 9216 + n0 + col;
        float acc[9];
#pragma unroll
        for (int v = 0; v < 9; ++v) acc[v] = 0.f;
#pragma unroll 8
        for (int k = ks * 128; k < ks * 128 + 128; ++k) { const float w = W[(size_t)k * 9216];
#pragma unroll
            for (int v = 0; v < 9; ++v) acc[v] += sv[v * DM + k] * w; }
#pragma unroll
        for (int v = 0; v < 9; ++v) red[(ks * 9 + v) * 64 + col] = acc[v];
        __syncthreads();
        for (int o = tid; o < 9 * 64; o += NTH) { const int v = o >> 6, cc = o & 63; float s = a.in[5][layer * 9216 + n0 + cc];
#pragma unroll
            for (int q = 0; q < 8; ++q) s += red[(q * 9 + v) * 64 + cc];
            mod[(size_t)(layer * 9 + v) * 9216 + n0 + cc] = s; }
        __syncthreads();
    }
    bf16_t* wgt = (bf16_t*)(a.ws + WS_WG);
    for (int i = blk * NTH + tid; i < 16 * 6144; i += G * NTH) { const int g = i / 6144, k = i % 6144; wgt[i] = f2bf(a.in[16][k * 16 + g]); }
}

__device__ __forceinline__ void rows_phase(const float* xs_lat, const float* xs_ctx, float* xd_lat, float* xd_ctx, const bf16_t* yp, const float* gpost, const float* modg, int jgate, float coef,
                                           bf16_t* hp, const float* gnext, const float* modn, int jshift, int skip_ctx, int blk, int G, int wave, int lane) {
    const bool has_y = yp != nullptr, has_h = hp != nullptr, has_xd = xd_lat != nullptr;
    for (int u = blk; u < T / 16; u += G) {
        const int R0 = u * 16, b = R0 / TB, t0 = R0 - b * TB; const bool isctx = t0 < CTX;
        if (skip_ctx && isctx) continue;
        const int v = isctx ? 8 : b;
        f32x4 gate[4], gp[4], gn[4], sh[4], sc[4];
#pragma unroll
        for (int j = 0; j < 4; ++j) { const int col = 256 * j + 4 * lane; const f32x4 z = {0.f, 0.f, 0.f, 0.f};
            gate[j] = has_y ? *(const f32x4*)(modg + (size_t)(v * 9 + jgate) * DM + col) : z; gp[j] = has_y ? *(const f32x4*)(gpost + col) : z;
            gn[j] = has_h ? *(const f32x4*)(gnext + col) : z; sh[j] = has_h ? *(const f32x4*)(modn + (size_t)(v * 9 + jshift) * DM + col) : z;
            sc[j] = has_h ? *(const f32x4*)(modn + (size_t)(v * 9 + jshift + 1) * DM + col) : z; }
#pragma unroll
        for (int rr = 0; rr < 2; ++rr) {
            const int t = t0 + wave * 2 + rr; const size_t R = (size_t)R0 + wave * 2 + rr;
            const size_t xo = isctx ? ((size_t)b * CTX + t) * DM : ((size_t)b * SEQ + (t - CTX)) * DM;
            const float* xs = (isctx ? xs_ctx : xs_lat) + xo;
            f32x4 x[4];
#pragma unroll
            for (int j = 0; j < 4; ++j) x[j] = *(const f32x4*)(xs + 256 * j + 4 * lane);
            if (has_y) {
                f32x4 yv[4]; float ss = 0.f;
#pragma unroll
                for (int j = 0; j < 4; ++j) { const u32x2 w = *(const u32x2*)(yp + R * DM + 256 * j + 4 * lane); yv[j] = (f32x4){bflo(w.x), bfhi(w.x), bflo(w.y), bfhi(w.y)};
                    ss += (yv[j][0] * yv[j][0] + yv[j][1] * yv[j][1]) + (yv[j][2] * yv[j][2] + yv[j][3] * yv[j][3]); }
                const float rstd = rsqrtf(wave_sum(ss) * (1.f / DM) + EPS);
#pragma unroll
                for (int j = 0; j < 4; ++j) x[j] += coef * gate[j] * (yv[j] * rstd * gp[j]);
            }
            if (has_xd) { float* xd = (isctx ? xd_ctx : xd_lat) + xo;
#pragma unroll
                for (int j = 0; j < 4; ++j) *(f32x4*)(xd + 256 * j + 4 * lane) = x[j]; }
            if (has_h) {
                float ss = 0.f;
#pragma unroll
                for (int j = 0; j < 4; ++j) ss += (x[j][0] * x[j][0] + x[j][1] * x[j][1]) + (x[j][2] * x[j][2] + x[j][3] * x[j][3]);
                const float rstd = rsqrtf(wave_sum(ss) * (1.f / DM) + EPS);
#pragma unroll
                for (int j = 0; j < 4; ++j) { const f32x4 hv = (x[j] * rstd * gn[j]) * (sc[j] + 1.f) + sh[j];
                    u32x2 w; w.x = cvt_pk_bf16(hv[0], hv[1]); w.y = cvt_pk_bf16(hv[2], hv[3]); *(u32x2*)(hp + R * DM + 256 * j + 4 * lane) = w; }
            }
        }
    }
}
__device__ __forceinline__ void rmsnorm2048_phase(bf16_t* R, const float* g, int gw, int NGW, int lane) {
    for (int r = gw; r < HT; r += NGW) {
        bf16_t* p = R + (size_t)r * INNER + 8 * lane; float v[4][8]; float ss = 0.f;
#pragma unroll
        for (int hh = 0; hh < 4; ++hh) { unpack8(*(const u32x4*)(p + 512 * hh), v[hh]);
#pragma unroll
            for (int j = 0; j < 8; ++j) ss += v[hh][j] * v[hh][j]; }
        const float rstd = rsqrtf(wave_sum(ss) * (1.f / INNER) + EPS);
#pragma unroll
        for (int hh = 0; hh < 4; ++hh) { const f32x4 g0 = *(const f32x4*)(g + 512 * hh + 8 * lane), g1 = *(const f32x4*)(g + 512 * hh + 8 * lane + 4);
#pragma unroll
            for (int j = 0; j < 4; ++j) { v[hh][j] = v[hh][j] * rstd * g0[j]; v[hh][4 + j] = v[hh][4 + j] * rstd * g1[j]; }
            *(u32x4*)(p + 512 * hh) = pack8(v[hh]); }
    }
}

__device__ __forceinline__ void conv_seg(int t, int& lo, int& hi) { if (t < CTX) { lo = 0; hi = CTX; } else { lo = CTX + ((t - CTX) >> 6) * 64; hi = lo + 64; } }
__device__ __forceinline__ int chunk_of_step(int dir, int step) { return dir == 0 ? step : (step < 2 ? 1 - step : NCH + 1 - step); }

__device__ __forceinline__ void mlstm_prep(const Args& a, ldsp lds, int blk, int G, int tid, int wave, int lane) {
    const bf16_t* XM = (const bf16_t*)(a.ws + WS_BIG); bf16_t* XC = (bf16_t*)(a.ws + WS_BIG + SLOT); bf16_t* V = (bf16_t*)(a.ws + WS_BIG + 2 * SLOT);
    float* GT = (float*)(a.ws + WS_GATES); const bf16_t* WG = (const bf16_t*)(a.ws + WS_WG);
    const float* conv_w = a.in[11]; const float* conv_b = a.in[12]; const float* wq = a.in[13]; const float* wk = a.in[14]; const float* wv = a.in[15]; const float* bg = a.in[17];
    constexpr int RS = 4112;
    LAS float* red = (LAS float*)(lds + 90112);
    const int tok = lane & 15, kq = lane >> 4;
    for (int u = blk; u < HT / 16; u += G) {
        const int r0 = u * 16, t0 = r0 % TB; int slo, shi; conv_seg(t0, slo, shi);
        for (int i = tid; i < 20 * 256; i += NTH) { const int rr = i >> 8, c16 = i & 255, t = t0 - 2 + rr;
            u32x4 val = {0u, 0u, 0u, 0u}; if (t >= slo && t < shi) val = *(const u32x4*)(XM + (size_t)(r0 - 2 + rr) * INNER + c16 * 8);
            *(LAS u32x4*)(lds + rr * RS + c16 * 16) = val; }
        __syncthreads();
        f32x4 acc = {0.f, 0.f, 0.f, 0.f};
#pragma unroll 1
        for (int ks = 0; ks < 8; ++ks) {
            const int ch0 = 256 * wave + 32 * ks + 8 * kq;
            float xm[5][8];
#pragma unroll
            for (int d = 0; d < 5; ++d) unpack8(*(const LAS u32x4*)(lds + (tok + d) * RS + ch0 * 2), xm[d]);
            float xc[8];
#pragma unroll
            for (int hh = 0; hh < 2; ++hh) { f32x4 s = *(const f32x4*)(conv_b + ch0 + 4 * hh);
#pragma unroll
                for (int d = 0; d < 5; ++d) { const f32x4 w = *(const f32x4*)(conv_w + d * INNER + ch0 + 4 * hh);
#pragma unroll
                    for (int c = 0; c < 4; ++c) s[c] += w[c] * xm[d][4 * hh + c]; }
#pragma unroll
                for (int c = 0; c < 4; ++c) xc[4 * hh + c] = silu_f(s[c]); }
            float q[8], k[8], v[8];
#pragma unroll
            for (int hh = 0; hh < 2; ++hh) { const int wb = (ch0 / 4 + hh) * 16;
#pragma unroll
                for (int d = 0; d < 4; ++d) { q[4 * hh + d] = 0.f; k[4 * hh + d] = 0.f; v[4 * hh + d] = 0.f; }
#pragma unroll
                for (int c = 0; c < 4; ++c) { const f32x4 w1 = *(const f32x4*)(wq + wb + 4 * c), w2 = *(const f32x4*)(wk + wb + 4 * c), w3 = *(const f32x4*)(wv + wb + 4 * c);
#pragma unroll
                    for (int d = 0; d < 4; ++d) { q[4 * hh + d] += xc[4 * hh + c] * w1[d]; k[4 * hh + d] += xc[4 * hh + c] * w2[d]; v[4 * hh + d] += xm[2][4 * hh + c] * w3[d]; } } }
            const u32x4 xcw = pack8(xc), vw = pack8(v), qw = pack8(q), kw = pack8(k);
            *(u32x4*)(XC + (size_t)(r0 + tok) * INNER + ch0) = xcw;
            *(u32x4*)(V + (size_t)(r0 + tok) * INNER + ch0) = vw;
            const bf16x8 bq = *(const bf16x8*)(WG + (size_t)tok * 6144 + ch0), bk = *(const bf16x8*)(WG + (size_t)tok * 6144 + 2048 + ch0), bv = *(const bf16x8*)(WG + (size_t)tok * 6144 + 4096 + ch0);
            acc = __builtin_amdgcn_mfma_f32_16x16x32_bf16(__builtin_bit_cast(bf16x8, qw), bq, acc, 0, 0, 0);
            acc = __builtin_amdgcn_mfma_f32_16x16x32_bf16(__builtin_bit_cast(bf16x8, kw), bk, acc, 0, 0, 0);
            acc = __builtin_amdgcn_mfma_f32_16x16x32_bf16(__builtin_bit_cast(bf16x8, vw), bv, acc, 0, 0, 0);
        }
#pragma unroll
        for (int j = 0; j < 4; ++j) red[wave * 256 + (4 * kq + j) * 16 + tok] = acc[j];
        __syncthreads();
        if (tid < 256) { float s = bg[tid & 15];
#pragma unroll
            for (int w = 0; w < 8; ++w) s += red[w * 256 + tid];
            GT[(size_t)(r0 + (tid >> 4)) * 16 + (tid & 15)] = s; }
        __syncthreads();
    }
}

__device__ __forceinline__ float wscan_add(float v, int lane) {
#pragma unroll
    for (int o = 1; o < 64; o <<= 1) { const float t = __shfl_up(v, o); if (lane >= o) v += t; }
    return v;
}
__device__ __forceinline__ float wscan_max(float v, int lane) {
#pragma unroll
    for (int o = 1; o < 64; o <<= 1) { const float t = __shfl_up(v, o); if (lane >= o) v = fmaxf(v, t); }
    return v;
}

__device__ __forceinline__ void mlstm_scan(const Args& a, ldsp lds, int vcu, int G, int tid, int wave, int lane) {
    const bf16_t* XC = (const bf16_t*)(a.ws + WS_BIG + SLOT); const bf16_t* V = (const bf16_t*)(a.ws + WS_BIG + 2 * SLOT);
    bf16_t* HSF = (bf16_t*)(a.ws + WS_BIG + 3 * SLOT); bf16_t* HSB = (bf16_t*)(a.ws + WS_BIG);
    const float* GT = (const float*)(a.ws + WS_GATES); const float* wq = a.in[13]; const float* wk = a.in[14];
    constexpr int LQ = 72, LT = 136, LC = 520;
    LAS bf16_t* QS = (LAS bf16_t*)(lds + 9216); LAS bf16_t* KS = (LAS bf16_t*)(lds + 27648); LAS bf16_t* KT = (LAS bf16_t*)(lds + 46080); LAS bf16_t* VT = (LAS bf16_t*)(lds + 63488);
    LAS bf16_t* CT = (LAS bf16_t*)(lds + 72192); LAS bf16_t* ST = (LAS bf16_t*)(lds + 9216);
    LAS float* LFV = (LAS float*)(lds + 0); LAS float* IGV = LFV + 128; LAS float* BV = LFV + 256; LAS float* MT = LFV + 384; LAS float* SCV = LFV + 512; LAS float* WGT = LFV + 640;
    LAS float* DEN = LFV + 768; LAS float* QN = LFV + 1024; LAS float* NA = LFV + 1152; LAS float* NBF = LFV + 1664; LAS float* SCAL = LFV + 2176;
    const int r16 = lane & 15, kq = lane >> 4;
    for (int u = vcu; u < 512; u += G) {
        const int js = u & 15, dir = (u >> 4) & 1, h = (u >> 5) & 3, bl = u >> 7;
        bf16_t* HS = dir ? HSB : HSF;
        f32x4 C[8][1][1];
#pragma unroll
        for (int i = 0; i < 8; ++i) C[i][0][0] = (f32x4){0.f, 0.f, 0.f, 0.f};
        for (int i = tid; i < 33280 / 16; i += NTH) ((LAS u32x4*)CT)[i] = (u32x4){0u, 0u, 0u, 0u};
        NA[tid] = 0.f; if (tid == 0) SCAL[0] = 0.f;
        __syncthreads();
        int ncur = 0;
#pragma unroll 1
        for (int step = 0; step < NCH; ++step) {
            const int c = chunk_of_step(dir, step);
            const size_t rb = (size_t)bl * TB + (size_t)c * CH;
            LAS float* Nold = ncur ? NBF : NA; LAS float* Nnew = ncur ? NA : NBF;
            if (tid < 128) { const float* g = GT + (rb + tid) * 16 + dir * 8 + h; IGV[tid] = g[0]; const float f = g[4]; LFV[tid] = fminf(f, 0.f) - log1pf(__expf(-fabsf(f))); }
            { const int s = tid >> 2, part = tid & 3; const bf16_t* vp = V + (rb + s) * INNER + h * 512 + js * 32 + part * 8;
                const u32x4 v0 = *(const u32x4*)vp; const unsigned w[4] = {v0.x, v0.y, v0.z, v0.w};
#pragma unroll
                for (int i = 0; i < 4; ++i) { VT[(part * 8 + 2 * i) * LT + s] = (bf16_t)(w[i] & 0xffffu); VT[(part * 8 + 2 * i + 1) * LT + s] = (bf16_t)(w[i] >> 16); } }
            __syncthreads();

#if !defined(MK_X_A)
            if (wave == 0) {
                const int p0 = 2 * lane, p1 = 2 * lane + 1, n0 = dir ? 127 - p0 : p0, n1 = dir ? 127 - p1 : p1;
                const float l0 = LFV[n0], l1 = LFV[n1], i0 = IGV[n0], i1 = IGV[n1];
                const float S = wscan_add(l0 + l1, lane), b1 = S, b0 = S - l1;
                const float a0 = i0 - b0, a1 = i1 - b1;
                const float PM = wscan_max(fmaxf(a0, a1), lane); float pex = __shfl_up(PM, 1); if (lane == 0) pex = -INFINITY;
                const float pm0 = fmaxf(pex, a0), pm1 = fmaxf(pex, fmaxf(a0, a1));
                const float mprev = SCAL[0];
                const float mt0 = b0 + fmaxf(mprev, pm0), mt1 = b1 + fmaxf(mprev, pm1);
                const float bend = __shfl(S, 63), pmend = __shfl(PM, 63);
                const float mnew = bend + fmaxf(mprev, pmend);
                BV[n0] = b0; BV[n1] = b1; MT[n0] = mt0; MT[n1] = mt1;
                SCV[n0] = __expf(b0 + mprev - mt0); SCV[n1] = __expf(b1 + mprev - mt1);
                WGT[n0] = __expf(bend - b0 + i0 - mnew); WGT[n1] = __expf(bend - b1 + i1 - mnew);
                if (lane == 0) { SCAL[1] = __expf(bend + mprev - mnew); SCAL[0] = mnew; }
            }
#endif

            __syncthreads();
            const float dec = SCAL[1];
#pragma unroll
            for (int i = 0; i < 8; ++i) C[i][0][0] *= dec;
            f32x4 Sacc[2][4], Iacc[2][1];
#pragma unroll
            for (int x = 0; x < 2; ++x)
#pragma unroll
                for (int y = 0; y < 4; ++y) Sacc[x][y] = (f32x4){0.f, 0.f, 0.f, 0.f};
#pragma unroll
            for (int x = 0; x < 2; ++x) Iacc[x][0] = (f32x4){0.f, 0.f, 0.f, 0.f};
            float qn_acc = 0.f;
#pragma unroll 1
            for (int i = 0; i < 8; ++i) {
                {
                    const int cg = tid & 15, rg = tid >> 4; const int wb = (h * 128 + i * 16 + cg) * 16;
                    u32x2 xw[4];
#pragma unroll
                    for (int rr = 0; rr < 4; ++rr) xw[rr] = *(const u32x2*)(XC + (rb + rg + 32 * rr) * INNER + h * 512 + i * 64 + cg * 4);
                    { f32x4 wv[4];
#pragma unroll
                      for (int cc = 0; cc < 4; ++cc) wv[cc] = *(const f32x4*)(wq + wb + 4 * cc);
#pragma unroll
                      for (int rr = 0; rr < 4; ++rr) { const int row = rg + 32 * rr;
                          const f32x4 q = bflo(xw[rr].x) * wv[0] + bfhi(xw[rr].x) * wv[1] + bflo(xw[rr].y) * wv[2] + bfhi(xw[rr].y) * wv[3];
                          u32x2 qp; qp.x = cvt_pk_bf16(q[0], q[1]); qp.y = cvt_pk_bf16(q[2], q[3]); *(LAS u32x2*)(QS + row * LQ + cg * 4) = qp; } }
                    { f32x4 wv[4];
#pragma unroll
                      for (int cc = 0; cc < 4; ++cc) wv[cc] = *(const f32x4*)(wk + wb + 4 * cc) * 0.04419417382415922f;
#pragma unroll
                      for (int rr = 0; rr < 4; ++rr) { const int row = rg + 32 * rr;
                          const f32x4 k = bflo(xw[rr].x) * wv[0] + bfhi(xw[rr].x) * wv[1] + bflo(xw[rr].y) * wv[2] + bfhi(xw[rr].y) * wv[3];
                          u32x2 kp; kp.x = cvt_pk_bf16(k[0], k[1]); kp.y = cvt_pk_bf16(k[2], k[3]); *(LAS u32x2*)(KS + row * LQ + cg * 4) = kp;
                          const float wg = WGT[row];
#pragma unroll
                          for (int cc = 0; cc < 4; ++cc) KT[(cg * 4 + cc) * LT + row] = f2bf(k[cc] * wg); } }
                }
                __syncthreads(); __builtin_amdgcn_sched_barrier(0);
                wmma<2, 4, 2>(Sacc, QS + (32 * (wave >> 1)) * LQ, LQ, KS + (64 * (wave & 1)) * LQ, LQ, lane);
                __builtin_amdgcn_sched_barrier(0);
                wmma<2, 1, 2>(Iacc, CT + i * 64, LC, QS + (16 * wave) * LQ, LQ, lane);
                __builtin_amdgcn_sched_barrier(0);
                {
                    const LAS bf16_t* Ak = KT + (16 * (wave >> 1)) * LT; const LAS bf16_t* Bv = VT + (16 * (wave & 1)) * LT;
#ifdef MK_X_SW
                    wmma<1, 1, 4>(C[0], Ak, LT, Bv, LT, lane);
#else
                    switch (i) {
                        case 0: wmma<1, 1, 4>(C[0], Ak, LT, Bv, LT, lane); break;
                        case 1: wmma<1, 1, 4>(C[1], Ak, LT, Bv, LT, lane); break;
                        case 2: wmma<1, 1, 4>(C[2], Ak, LT, Bv, LT, lane); break;
                        case 3: wmma<1, 1, 4>(C[3], Ak, LT, Bv, LT, lane); break;
                        case 4: wmma<1, 1, 4>(C[4], Ak, LT, Bv, LT, lane); break;
                        case 5: wmma<1, 1, 4>(C[5], Ak, LT, Bv, LT, lane); break;
                        case 6: wmma<1, 1, 4>(C[6], Ak, LT, Bv, LT, lane); break;
                        default: wmma<1, 1, 4>(C[7], Ak, LT, Bv, LT, lane); break;
                    }
#endif
                }
                __builtin_amdgcn_sched_barrier(0);

#if !defined(MK_X_E)
                {
                    const int t = tid >> 2, part = tid & 3;
#if !defined(MK_X_E1)
#pragma unroll
                    for (int hh = 0; hh < 2; ++hh) { float qa[8]; unpack8(*(const LAS u32x4*)(QS + t * LQ + part * 16 + 8 * hh), qa);
                        const f32x4 n0 = *(const LAS f32x4*)(Nold + i * 64 + part * 16 + 8 * hh), n1 = *(const LAS f32x4*)(Nold + i * 64 + part * 16 + 8 * hh + 4);
                        qn_acc += (qa[0] * n0[0] + qa[1] * n0[1]) + (qa[2] * n0[2] + qa[3] * n0[3]) + (qa[4] * n1[0] + qa[5] * n1[1]) + (qa[6] * n1[2] + qa[7] * n1[3]); }
#endif
#if !defined(MK_X_E2)
                    const int d = tid >> 3, p8 = tid & 7; float ks = 0.f;
#pragma unroll
                    for (int hh = 0; hh < 2; ++hh) { float kv[8]; unpack8(*(const LAS u32x4*)(KT + d * LT + p8 * 16 + 8 * hh), kv);
                        ks += ((kv[0] + kv[1]) + (kv[2] + kv[3])) + ((kv[4] + kv[5]) + (kv[6] + kv[7])); }
                    ks += __shfl_xor(ks, 1); ks += __shfl_xor(ks, 2); ks += __shfl_xor(ks, 4);
                    if (p8 == 0) Nnew[i * 64 + d] = dec * Nold[i * 64 + d] + ks;
#endif
                }
#endif

                __syncthreads(); __builtin_amdgcn_sched_barrier(0);
            }
#pragma unroll
            for (int i = 0; i < 8; ++i) { u32x2 w; w.x = cvt_pk_bf16(C[i][0][0][0], C[i][0][0][1]); w.y = cvt_pk_bf16(C[i][0][0][2], C[i][0][0][3]);
                *(LAS u32x2*)(CT + (16 * (wave & 1) + r16) * LC + 64 * i + 16 * (wave >> 1) + 4 * kq) = w; }
            qn_acc += __shfl_xor(qn_acc, 1); qn_acc += __shfl_xor(qn_acc, 2);
            if ((tid & 3) == 0) QN[tid >> 2] = qn_acc;

#if !defined(MK_X_G)
            float cterm[4];
#pragma unroll
            for (int ni = 0; ni < 4; ++ni) { const int col = 64 * (wave & 1) + 16 * ni + r16; cterm[ni] = IGV[col] - BV[col]; }
            const float sgn = dir ? -1.f : 1.f, fbase = (float)(32 * (wave >> 1) + 4 * kq - 64 * (wave & 1) - r16);
#pragma unroll
            for (int mi = 0; mi < 2; ++mi)
#pragma unroll
                for (int jj = 0; jj < 4; ++jj) { const int row = 32 * (wave >> 1) + 16 * mi + 4 * kq + jj; const float brow = BV[row] - MT[row]; float rs = 0.f;
#pragma unroll
                    for (int ni = 0; ni < 4; ++ni) { const int col = 64 * (wave & 1) + 16 * ni + r16;
                        const float pen = fminf(0.f, sgn * (fbase + (float)(16 * mi + jj - 16 * ni))) * 1e30f;
                        const float e = Sacc[mi][ni][jj] * __expf(brow + cterm[ni] + pen); const bf16_t hb = f2bf(e); ST[row * LT + col] = hb; rs += bf1(hb); }
                    rs += __shfl_xor(rs, 1); rs += __shfl_xor(rs, 2); rs += __shfl_xor(rs, 4); rs += __shfl_xor(rs, 8);
                    if (r16 == 0) DEN[(wave & 1) * 128 + row] = rs;
                    __builtin_amdgcn_sched_barrier(0); }
#endif

            __syncthreads();
            f32x4 Nacc[2][1];
#pragma unroll
            for (int x = 0; x < 2; ++x) Nacc[x][0] = (f32x4){0.f, 0.f, 0.f, 0.f};
            wmma<2, 1, 4>(Nacc, VT, LT, ST + (16 * wave) * LT, LT, lane);
            { const int t = 16 * wave + r16; const float scv = SCV[t]; const float den = (DEN[t] + DEN[128 + t]) + scv * QN[t];
              const float inv = 1.f / fmaxf(fabsf(den), __expf(-MT[t]));
              bf16_t* op = HS + (rb + t) * INNER + h * 512 + js * 32 + 4 * kq;
#pragma unroll
              for (int mi = 0; mi < 2; ++mi) { float o[4];
#pragma unroll
                  for (int jj = 0; jj < 4; ++jj) o[jj] = (Nacc[mi][0][jj] + scv * Iacc[mi][0][jj]) * inv;
                  u32x2 w; w.x = cvt_pk_bf16(o[0], o[1]); w.y = cvt_pk_bf16(o[2], o[3]); *(u32x2*)(op + 16 * mi) = w; } }
            __syncthreads();
            ncur ^= 1;
        }
    }
}
__device__ __forceinline__ void mlstm_readout(const Args& a, int gw, int NGW, int lane) {
    const bf16_t* XC = (const bf16_t*)(a.ws + WS_BIG + SLOT); bf16_t* HSF = (bf16_t*)(a.ws + WS_BIG + 3 * SLOT); const bf16_t* HSB = (const bf16_t*)(a.ws + WS_BIG);
    const float* ng = a.in[18]; const float* sk = a.in[19];
    for (int r = gw; r < HT; r += NGW) {
#pragma unroll
        for (int hh = 0; hh < 4; ++hh) { const size_t o = (size_t)r * INNER + 512 * hh + 8 * lane; const int col = 512 * hh + 8 * lane;
            float v[8], w[8], xc[8]; unpack8(*(const u32x4*)(HSF + o), v); unpack8(*(const u32x4*)(HSB + o), w); unpack8(*(const u32x4*)(XC + o), xc);
            float s = 0.f;
#pragma unroll
            for (int j = 0; j < 8; ++j) { v[j] += w[j]; s += v[j]; }
            const float mu = wave_sum(s) * (1.f / 512.f); float s2 = 0.f;
#pragma unroll
            for (int j = 0; j < 8; ++j) { v[j] -= mu; s2 += v[j] * v[j]; }
            const float rstd = rsqrtf(wave_sum(s2) * (1.f / 512.f) + EPS);
            const f32x4 g0 = *(const f32x4*)(ng + col), g1 = *(const f32x4*)(ng + col + 4), k0 = *(const f32x4*)(sk + col), k1 = *(const f32x4*)(sk + col + 4);
#pragma unroll
            for (int j = 0; j < 4; ++j) { v[j] = v[j] * rstd * g0[j] + k0[j] * xc[j]; v[4 + j] = v[4 + j] * rstd * g1[j] + k1[j] * xc[4 + j]; }
            *(u32x4*)(HSF + o) = pack8(v); }
    }
}

__device__ __forceinline__ void ssd_prep(const Args& a, int blk, int G, int tid) {
    const bf16_t* XP = (const bf16_t*)(a.ws + WS_BIG); bf16_t* XO = (bf16_t*)(a.ws + WS_BIG + 2 * SLOT);
    const float* conv_w = a.in[22]; const float* conv_b = a.in[23];
    const int ch = tid * 8;
    float cw[5][8], cb[8];
#pragma unroll
    for (int d = 0; d < 5; ++d) { const f32x4 w0 = *(const f32x4*)(conv_w + d * 4096 + ch), w1 = *(const f32x4*)(conv_w + d * 4096 + ch + 4);
#pragma unroll
        for (int c = 0; c < 4; ++c) { cw[d][c] = w0[c]; cw[d][4 + c] = w1[c]; } }
    { const f32x4 b0 = *(const f32x4*)(conv_b + ch), b1 = *(const f32x4*)(conv_b + ch + 4);
#pragma unroll
      for (int c = 0; c < 4; ++c) { cb[c] = b0[c]; cb[4 + c] = b1[c]; } }
    for (int u = blk; u < HT / 16; u += G) {
        const int r0 = u * 16, t0 = r0 % TB; int slo, shi; conv_seg(t0, slo, shi);
        float win[5][8];
#pragma unroll
        for (int d = 0; d < 4; ++d) { const int t = t0 - 2 + d; u32x4 w = {0u, 0u, 0u, 0u}; if (t >= slo && t < shi) w = *(const u32x4*)(XP + (size_t)(r0 - 2 + d) * 4096 + ch); unpack8(w, win[d]); }
#pragma unroll
        for (int tt = 0; tt < 16; ++tt) {
            { const int t = t0 + tt + 2; u32x4 w = {0u, 0u, 0u, 0u}; if (t >= slo && t < shi) w = *(const u32x4*)(XP + (size_t)(r0 + tt + 2) * 4096 + ch); unpack8(w, win[4]); }
            float o[8];
#pragma unroll
            for (int c = 0; c < 8; ++c) { float s = cb[c];
#pragma unroll
                for (int d = 0; d < 5; ++d) s += cw[d][c] * win[d][c];
                o[c] = silu_f(s); }
            *(u32x4*)(XO + (size_t)(r0 + tt) * 4096 + ch) = pack8(o);
#pragma unroll
            for (int d = 0; d < 4; ++d)
#pragma unroll
                for (int c = 0; c < 8; ++c) win[d][c] = win[d + 1][c];
        }
    }
}
__device__ __forceinline__ void ssd_scan(const Args& a, ldsp lds, int vcu, int G, int tid, int wave, int lane) {
    const bf16_t* X = (const bf16_t*)(a.ws + WS_BIG + 2 * SLOT); bf16_t* YF = (bf16_t*)(a.ws + WS_BIG); bf16_t* YB = (bf16_t*)(a.ws + WS_BIG + SLOT);
    const float* DT = (const float*)(a.ws + WS_DT);
    constexpr int LT = 136;
    LAS bf16_t* CM = (LAS bf16_t*)(lds + 4096); LAS bf16_t* BM = (LAS bf16_t*)(lds + 38912); LAS bf16_t* BT = (LAS bf16_t*)(lds + 73728); LAS bf16_t* XT = (LAS bf16_t*)(lds + 108544); LAS bf16_t* HB = (LAS bf16_t*)(lds + 125952);
    LAS float* DTV = (LAS float*)(lds + 0); LAS float* CS = DTV + 128; LAS float* ECS = DTV + 256; LAS float* WG = DTV + 384; LAS float* SCAL = DTV + 512;
    const int r16 = lane & 15, kq = lane >> 4;
    for (int u = vcu; u < 256; u += G) {
        const int hr = u & 3, dir = (u >> 2) & 1, g = (u >> 3) & 7, bl = u >> 6, head = g * 4 + hr;
        bf16_t* Y = dir ? YB : YF;
        const float a_neg = -__expf(a.in[25][dir * 32 + head]), dtb = a.in[24][dir * 32 + head], dsk = dir ? 0.f : a.in[26][head];
        f32x4 Hs[1][4];
#pragma unroll
        for (int x = 0; x < 4; ++x) Hs[0][x] = (f32x4){0.f, 0.f, 0.f, 0.f};
        for (int i = tid; i < 17408 / 16; i += NTH) ((LAS u32x4*)HB)[i] = (u32x4){0u, 0u, 0u, 0u};
        __syncthreads();
#pragma unroll 1
        for (int step = 0; step < NCH; ++step) {
            const int c = chunk_of_step(dir, step);
            const size_t rb = (size_t)bl * TB + (size_t)c * CH;
            if (tid < 128) { const float dt = softplus_f(DT[(rb + tid) * 64 + dir * 32 + head] + dtb); DTV[tid] = dt; CS[tid] = dt * a_neg; }
            __syncthreads();
            if (wave == 0) {
                const int p0 = 2 * lane, p1 = 2 * lane + 1, n0 = dir ? 127 - p0 : p0, n1 = dir ? 127 - p1 : p1;
                const float l0 = CS[n0], l1 = CS[n1];
                const float S = wscan_add(l0 + l1, lane), c1 = S, c0 = S - l1, cend = __shfl(S, 63);
                CS[n0] = c0; CS[n1] = c1; ECS[n0] = __expf(c0); ECS[n1] = __expf(c1);
                WG[n0] = __expf(cend - c0) * DTV[n0]; WG[n1] = __expf(cend - c1) * DTV[n1];
                if (lane == 0) SCAL[0] = __expf(cend);
            }
            __syncthreads();
            { const int rg = tid >> 4, c16 = tid & 15;
#pragma unroll
              for (int rr = 0; rr < 4; ++rr) { const int row = rg + 32 * rr; const bf16_t* xr = X + (rb + row) * 4096;
                  const u32x4 cm = *(const u32x4*)(xr + 3072 + g * 128 + c16 * 8), bm = *(const u32x4*)(xr + 2048 + g * 128 + c16 * 8);
                  *(LAS u32x4*)(CM + row * LT + c16 * 8) = cm; *(LAS u32x4*)(BM + row * LT + c16 * 8) = bm;
                  float bf[8]; unpack8(bm, bf); const float wg = WG[row];
#pragma unroll
                  for (int e = 0; e < 8; ++e) BT[(c16 * 8 + e) * LT + row] = f2bf(bf[e] * wg); }
              const int s = tid >> 2, part = tid & 3; const bf16_t* xp = X + (rb + s) * 4096 + head * 64 + part * 16;
              const u32x4 v0 = *(const u32x4*)xp, v1 = *(const u32x4*)(xp + 8); const unsigned w[8] = {v0.x, v0.y, v0.z, v0.w, v1.x, v1.y, v1.z, v1.w};
#pragma unroll
              for (int i = 0; i < 8; ++i) { XT[(part * 16 + 2 * i) * LT + s] = (bf16_t)(w[i] & 0xffffu); XT[(part * 16 + 2 * i + 1) * LT + s] = (bf16_t)(w[i] >> 16); } }
            __syncthreads();
            f32x4 CB[2][4], Iacc[4][1];
#pragma unroll
            for (int x = 0; x < 2; ++x)
#pragma unroll
                for (int y = 0; y < 4; ++y) CB[x][y] = (f32x4){0.f, 0.f, 0.f, 0.f};
#pragma unroll
            for (int x = 0; x < 4; ++x) Iacc[x][0] = (f32x4){0.f, 0.f, 0.f, 0.f};
            wmma<2, 4, 4>(CB, CM + (32 * (wave >> 1)) * LT, LT, BM + (64 * (wave & 1)) * LT, LT, lane);
            wmma<4, 1, 4>(Iacc, HB, LT, CM + (16 * wave) * LT, LT, lane);
            __syncthreads();
            LAS bf16_t* MM = CM;
            const float sgn = dir ? -1.f : 1.f, fbase = (float)(32 * (wave >> 1) + 4 * kq - 64 * (wave & 1) - r16);
            float ccs[4], cdt[4];
#pragma unroll
            for (int ni = 0; ni < 4; ++ni) { const int col = 64 * (wave & 1) + 16 * ni + r16; ccs[ni] = CS[col]; cdt[ni] = DTV[col]; }
#pragma unroll
            for (int mi = 0; mi < 2; ++mi)
#pragma unroll
                for (int jj = 0; jj < 4; ++jj) { const int row = 32 * (wave >> 1) + 16 * mi + 4 * kq + jj; const float cr = CS[row];
#pragma unroll
                    for (int ni = 0; ni < 4; ++ni) { const int col = 64 * (wave & 1) + 16 * ni + r16;
                        const float pen = fminf(0.f, sgn * (fbase + (float)(16 * mi + jj - 16 * ni))) * 1e30f;
                        const float e = CB[mi][ni][jj] * __expf(fminf(cr - ccs[ni], 0.f) + pen) * cdt[ni]; MM[row * LT + col] = f2bf(e); } }
            __syncthreads();
            f32x4 Yacc[4][1];
#pragma unroll
            for (int x = 0; x < 4; ++x) Yacc[x][0] = (f32x4){0.f, 0.f, 0.f, 0.f};
            wmma<4, 1, 4>(Yacc, XT, LT, MM + (16 * wave) * LT, LT, lane);
            { const int t = 16 * wave + r16; const float ecs = ECS[t]; bf16_t* op = Y + (rb + t) * INNER + head * 64 + 4 * kq;
#pragma unroll
              for (int mi = 0; mi < 4; ++mi) { float o[4];
#pragma unroll
                  for (int jj = 0; jj < 4; ++jj) o[jj] = Yacc[mi][0][jj] + ecs * Iacc[mi][0][jj] + dsk * bf1(XT[(16 * mi + 4 * kq + jj) * LT + t]);
                  u32x2 w; w.x = cvt_pk_bf16(o[0], o[1]); w.y = cvt_pk_bf16(o[2], o[3]); *(u32x2*)(op + 16 * mi) = w; } }
            const float dec = SCAL[0];
#pragma unroll
            for (int x = 0; x < 4; ++x) Hs[0][x] *= dec;
            wmma<1, 4, 4>(Hs, XT + (16 * (wave >> 1)) * LT, LT, BT + (64 * (wave & 1)) * LT, LT, lane);
#pragma unroll
            for (int tt = 0; tt < 4; ++tt)
#pragma unroll
                for (int jj = 0; jj < 4; ++jj) HB[(16 * (wave >> 1) + 4 * kq + jj) * LT + 64 * (wave & 1) + 16 * tt + r16] = f2bf(Hs[0][tt][jj]);
            __syncthreads();
        }
    }
}

typedef const __attribute__((address_space(4))) Args* KArgsPtr;
__global__ void __launch_bounds__(NTH, 2) fwd(Args a_unused) {
    extern __shared__ __attribute__((aligned(16))) unsigned char lds_raw[];
    const ldsp lds = (ldsp)lds_raw;
    const int G = gridDim.x;
    if (threadIdx.x == 0) *(LAS u32x4*)(lds + LDS_XB) = (u32x4){0u, 0u, 0u, 0u};
    __syncthreads();
    XcdBarrier bar = xcd_barrier_post((unsigned*)(a_unused.ws + WS_CTL), (volatile LAS unsigned*)(lds + LDS_XB));
    const int NGW = G * NWAVES;
#define IDS int tid_ = threadIdx.x, blk_ = blockIdx.x; KArgsPtr kp_ = (KArgsPtr)__builtin_amdgcn_kernarg_segment_ptr(); asm volatile("" : "+v"(tid_), "+s"(blk_), "+s"(kp_)); \
    const Args& a = *(const Args*)kp_; unsigned char* const ws = a.ws; \
    const int lane_ = tid_ & 63, wave_ = __builtin_amdgcn_readfirstlane(tid_ >> 6), gw_ = blk_ * NWAVES + wave_, vcu_ = (G % 8 == 0) ? (blk_ % 8) * (G / 8) + blk_ / 8 : blk_; \
    bf16_t* const W = (bf16_t*)(ws + WS_W); bf16_t* const Hb = (bf16_t*)(ws + WS_H); bf16_t* const Yb = (bf16_t*)(ws + WS_Y); bf16_t* const BIG = (bf16_t*)(ws + WS_BIG); \
    float* const ctxs = (float*)(ws + WS_CTXS); const float* const mod = (const float*)(ws + WS_MOD); \
    (void)lane_; (void)wave_; (void)gw_; (void)vcu_; (void)W; (void)Hb; (void)Yb; (void)BIG; (void)ctxs; (void)mod;
#ifndef MK_ONLY
#define MK_ONLY 0
#endif
#define SEL(k) (MK_ONLY == 0 || MK_ONLY == (k))
#define PH_END xcd_barrier(bar)

    if (SEL(1)) { IDS convert_layer(a, 0, lds, gw_, NGW, wave_, lane_); __syncthreads(); mods_phase(a, lds, blk_, G, tid_); } PH_END;
    if (SEL(2)) { IDS rows_phase(a.in[0], a.in[2], nullptr, nullptr, nullptr, nullptr, nullptr, 0, 0.f, Hb, a.in[6], mod, 0, 0, blk_, G, wave_, lane_); } PH_END;

#pragma unroll 1
    for (int layer = 0; layer < 2; ++layer) {
        const bool last = layer == 1;
#pragma unroll 1
        for (int sub = 0; sub < 2; ++sub) {
            if (SEL(3)) { IDS pg8::Gemm g{Hb, W + (sub ? WO_GU2 : WO_GU1), T, 2 * DFF, DM}; pg8::StaticOrder S; S.init(T, 2 * DFF, G, blk_); EpiSwiglu E{BIG, DFF};
                pg8::gemm_phase<EpiSwiglu, pg8::StaticOrder, false>(lds, g, S, E, nullptr); } PH_END;
            if (SEL(4)) { IDS pg8::Gemm g{BIG, W + (sub ? WO_D2 : WO_D1), T, DM, DFF}; pg8::StaticOrder S; S.init(T, DM, G, blk_); pg8::EpiBf16<0> E{Yb, DM, nullptr, 0, 0};
                pg8::gemm_phase<pg8::EpiBf16<0>, pg8::StaticOrder, false>(lds, g, S, E, nullptr); } PH_END;
            if (sub == 0) {
                if (SEL(2)) { IDS const float* gl = a.in[6] + (size_t)layer * 6 * DM; const float* modl = mod + (size_t)layer * 9 * 9216;
                    rows_phase(layer == 0 ? a.in[0] : a.out, layer == 0 ? a.in[2] : ctxs, a.out, ctxs, Yb, gl + 1 * DM, modl, 2, 0.5f, Hb, gl + 2 * DM, modl, 3, 0, blk_, G, wave_, lane_); } PH_END;
                if (layer == 0) {
#pragma unroll 1
                    for (int half = 0; half < 2; ++half) {
                        if (SEL(5)) { IDS pg8::Gemm g{Hb + (size_t)half * HT * DM, W + WO_IN, HT, INNER, DM}; pg8::StaticOrder S; S.init(HT, INNER, G, blk_); pg8::EpiBf16<0> E{BIG, INNER, nullptr, 0, 0};
                            pg8::gemm_phase<pg8::EpiBf16<0>, pg8::StaticOrder, false>(lds, g, S, E, nullptr); } PH_END;
                        if (SEL(6)) { IDS mlstm_prep(a, lds, blk_, G, tid_, wave_, lane_); } PH_END;
                        if (SEL(7)) { IDS mlstm_scan(a, lds, vcu_, G, tid_, wave_, lane_); } PH_END;
                        if (SEL(8)) { IDS mlstm_readout(a, gw_, NGW, lane_); } PH_END;
                        if (SEL(9)) { IDS pg8::Gemm g{Hb + (size_t)half * HT * DM, W + WO_IN + (size_t)INNER * DM, HT, INNER, DM}; pg8::StaticOrder S; S.init(HT, INNER, G, blk_);
                            EpiMulSilu<false> E{(bf16_t*)(ws + WS_BIG + 3 * SLOT), nullptr, INNER}; pg8::gemm_phase<EpiMulSilu<false>, pg8::StaticOrder, false>(lds, g, S, E, nullptr); } PH_END;
                        if (SEL(10)) { IDS pg8::Gemm g{(const bf16_t*)(ws + WS_BIG + 3 * SLOT), W + WO_OUT, HT, DM, INNER}; pg8::StaticOrder S; S.init(HT, DM, G, blk_);
                            pg8::EpiBf16<0> E{Yb + (size_t)half * HT * DM, DM, nullptr, 0, 0}; pg8::gemm_phase<pg8::EpiBf16<0>, pg8::StaticOrder, false>(lds, g, S, E, nullptr); } PH_END;
                    }
                } else {
#pragma unroll 1
                    for (int half = 0; half < 2; ++half) {
                        if (SEL(11)) { IDS pg8::Gemm g{Hb + (size_t)half * HT * DM, W + WO_IN + (size_t)INNER * DM, HT, 4352, DM}; pg8::StaticOrder S; S.init(HT, 4352, G, blk_); EpiSsdIn E{BIG, (float*)(ws + WS_DT)};
                            pg8::gemm_phase<EpiSsdIn, pg8::StaticOrder, false>(lds, g, S, E, nullptr); } PH_END;
                        if (SEL(12)) { IDS ssd_prep(a, blk_, G, tid_); } PH_END;
                        if (SEL(13)) { IDS ssd_scan(a, lds, vcu_, G, tid_, wave_, lane_); } PH_END;
                        if (SEL(14)) { IDS pg8::Gemm g{Hb + (size_t)half * HT * DM, W + WO_IN, HT, INNER, DM}; pg8::StaticOrder S; S.init(HT, INNER, G, blk_);
                            EpiMulSilu<true> E{BIG, (const bf16_t*)(ws + WS_BIG + SLOT), INNER}; pg8::gemm_phase<EpiMulSilu<true>, pg8::StaticOrder, false>(lds, g, S, E, nullptr); } PH_END;
                        if (SEL(15)) { IDS rmsnorm2048_phase(BIG, a.in[27], gw_, NGW, lane_); } PH_END;
                        if (SEL(16)) { IDS pg8::Gemm g{BIG, W + WO_OUT, HT, DM, INNER}; pg8::StaticOrder S; S.init(HT, DM, G, blk_);
                            pg8::EpiBf16<0> E{Yb + (size_t)half * HT * DM, DM, nullptr, 0, 0}; pg8::gemm_phase<pg8::EpiBf16<0>, pg8::StaticOrder, false>(lds, g, S, E, nullptr); } PH_END;
                    }
                }
                if (SEL(2)) { IDS const float* gl = a.in[6] + (size_t)layer * 6 * DM; const float* modl = mod + (size_t)layer * 9 * 9216;
                    rows_phase(a.out, ctxs, a.out, ctxs, Yb, gl + 3 * DM, modl, 5, 1.0f, Hb, gl + 4 * DM, modl, 6, last ? 1 : 0, blk_, G, wave_, lane_); } PH_END;
            } else {
                if (SEL(17)) { IDS const float* gl = a.in[6] + (size_t)layer * 6 * DM; const float* modl = mod + (size_t)layer * 9 * 9216;
                    rows_phase(a.out, ctxs, a.out, ctxs, Yb, gl + 5 * DM, modl, 8, 0.5f, last ? nullptr : Hb, gl + 6 * DM, modl + 9 * 9216, 0, last ? 1 : 0, blk_, G, wave_, lane_);
                    if (!last) { __syncthreads(); convert_layer(a, 1, lds, gw_, NGW, wave_, lane_); } }
                if (!last) PH_END;
            }
        }
    }
#undef PH_END
#undef IDS
}
constexpr int N_PHASES = 2 + 2 * (2 + 1 + 12 + 1 + 2 + 1);
}

extern "C" void kernel_launch(void* const* d_in, const int* in_sizes, int n_in, void* d_out, int out_size, void* d_ws, size_t ws_size, hipStream_t stream) {
    static int grid = 0;
    if (grid == 0) {
        if (n_in != 29 || out_size != mk::NB * mk::SEQ * mk::DM || ws_size < mk::WS_END) {
            fprintf(stderr, "kernel_launch: unexpected problem (n_in %d, out %d, ws %zu, need %zu); nothing launched\n", n_in, out_size, ws_size, (size_t)mk::WS_END); grid = -1; return; }
        int dev = 0, cus = 0, per_cu = 0;
        if (hipGetDevice(&dev) != hipSuccess || hipDeviceGetAttribute(&cus, hipDeviceAttributeMultiprocessorCount, dev) != hipSuccess) { grid = -1; return; }
        if (hipFuncSetAttribute((const void*)mk::fwd, hipFuncAttributeMaxDynamicSharedMemorySize, mk::LDS_BYTES) != hipSuccess) { fprintf(stderr, "kernel_launch: hipFuncSetAttribute failed\n"); grid = -1; return; }
        if (hipOccupancyMaxActiveBlocksPerMultiprocessor(&per_cu, (const void*)mk::fwd, mk::NTH, mk::LDS_BYTES) != hipSuccess || per_cu < 1) {
            fprintf(stderr, "kernel_launch: occupancy query reports %d workgroups per CU; nothing launched\n", per_cu); (void)hipGetLastError(); grid = -1; return; }
        grid = cus;
    }
    if (grid < 0) return;
    if (hipMemsetAsync((char*)d_ws + mk::WS_CTL, 0, mk::CTL_ZERO_BYTES, stream) != hipSuccess) return;
    mk::Args a{};
    for (int i = 0; i < 29; ++i) a.in[i] = (const float*)d_in[i];
    a.out = (float*)d_out; a.ws = (unsigned char*)d_ws; a.ph_lo = 0; a.ph_hi = 0;
    hipLaunchKernelGGL(mk::fwd, dim3(grid), dim3(mk::NTH), mk::LDS_BYTES, stream, a);
}
```

```cpp
#include <hip/hip_runtime.h>
#include <cstdio>
#include <cstdint>
#define XB_TMO      128
#define XB_XCNT(j)  (256  + 64 * (j))
#define XB_XSUB(j)  (1280 + 64 * (j))
#define XB_XGEN(j)  (2304 + 64 * (j))
#define XB_TOP      3328
#define XB_TOPGEN   3392
#define XCD_BAR_WORDS 3456
#define XB_SPIN_CAP (1u << 18)
#define LAS __attribute__((address_space(3)))

__device__ __forceinline__ unsigned xb_ld(unsigned* p)              { return __hip_atomic_load(p, __ATOMIC_RELAXED, __HIP_MEMORY_SCOPE_AGENT); }
__device__ __forceinline__ unsigned xb_add(unsigned* p, unsigned v) { return __hip_atomic_fetch_add(p, v, __ATOMIC_RELAXED, __HIP_MEMORY_SCOPE_AGENT); }
__device__ __forceinline__ unsigned xb_xcc_id() { return (unsigned)__builtin_amdgcn_s_getreg((3 << 11) | 20) & 0xFu; }
#define XB_SPIN(cond, bar) do { unsigned _sp = 0; while (cond) { __builtin_amdgcn_s_sleep(1); \
    if ((++_sp & 255u) == 0u) { if (xb_ld(&(bar)[XB_TMO])) break; if (_sp > XB_SPIN_CAP) { atomicAdd(&(bar)[XB_TMO], 1u); break; } } } } while (0)

struct XcdBarrier {
    unsigned* bar; unsigned x;
    volatile LAS unsigned* st;
};

__device__ __forceinline__ XcdBarrier xcd_barrier_post(unsigned* bar, volatile LAS unsigned* st) {
    XcdBarrier b; b.bar = bar; b.x = xb_xcc_id(); b.st = st;
    if (threadIdx.x == 0) (void)xb_add(&bar[XB_XCNT(b.x)], 1u);
    return b;
}
__device__ __forceinline__ void xcd_barrier_complete(unsigned* bar, unsigned x, unsigned& nloc, unsigned& nx) {
    const unsigned G = gridDim.x * gridDim.y * gridDim.z;
    unsigned sum, cnt, mine, sp = 0u;
    for (;;) {
        sum = 0u; cnt = 0u; mine = 0u;
#pragma unroll
        for (unsigned j = 0; j < 16; ++j) { const unsigned c = xb_ld(&bar[XB_XCNT(j)]); sum += c; cnt += (c > 0u) ? 1u : 0u; mine = (j == x) ? c : mine; }
        if (sum == G) break;
        __builtin_amdgcn_s_sleep(1);
        if ((++sp & 255u) == 0u) { if (xb_ld(&bar[XB_TMO])) break; if (sp > XB_SPIN_CAP) { atomicAdd(&bar[XB_TMO], 1u); break; } }
    }
    nloc = mine > 0u ? mine : 1u; nx = cnt > 0u ? cnt : 1u;
}

__device__ __forceinline__ void xcd_barrier(const XcdBarrier& b) {
    asm volatile("s_waitcnt vmcnt(0)" ::: "memory");
    __syncthreads();
    if (threadIdx.x == 0) {
        unsigned* bar = b.bar;
        __builtin_amdgcn_s_waitcnt(0);
        unsigned nloc = b.st[0], nx = b.st[1];
        if (nloc == 0u) { xcd_barrier_complete(bar, b.x, nloc, nx); b.st[0] = nloc; b.st[1] = nx; }
        const unsigned old = xb_add(&bar[XB_XSUB(b.x)], 1u);
        const unsigned gen = old / nloc;
        if (old + 1u == (gen + 1u) * nloc) {
            __builtin_amdgcn_fence(__ATOMIC_RELEASE, "agent");
            asm volatile("s_waitcnt vmcnt(0)" ::: "memory");
            const unsigned og = xb_add(&bar[XB_TOP], 1u);
            const unsigned tg = og / nx;
            if (og + 1u == (tg + 1u) * nx) xb_add(&bar[XB_TOPGEN], 1u);
            else XB_SPIN(xb_ld(&bar[XB_TOPGEN]) == tg, bar);
            __builtin_amdgcn_fence(__ATOMIC_ACQUIRE, "agent");
            xb_add(&bar[XB_XGEN(b.x)], 1u);
            asm volatile("s_waitcnt vmcnt(0)" ::: "memory");
        } else {
            XB_SPIN(xb_ld(&bar[XB_XGEN(b.x)]) == gen, bar);
            __builtin_amdgcn_fence(__ATOMIC_ACQUIRE, "agent");
            asm volatile("s_waitcnt vmcnt(0)" ::: "memory");
        }
    }
    __syncthreads();
}
namespace pg8 {
#define PG8_LAS __attribute__((address_space(3)))
typedef unsigned short bf16_t;
typedef short bf16x8 __attribute__((ext_vector_type(8)));
typedef float f32x4 __attribute__((ext_vector_type(4)));
typedef unsigned u32x4 __attribute__((ext_vector_type(4)));
constexpr int BM = 256, BK = 64, HALF = 128, HTB = HALF * BK * 2  , STAGE_BYTES = 8 * HTB, NXCD = 8, WGM = 8;

__host__ __device__ __forceinline__ int lds_byte(int r, int c) { const int st = (r >> 4) * 2 + (c >> 5), rr = r & 15, cc = c & 31, ob = rr * 64 + cc * 2; return st * 1024 + (ob ^ (((ob >> 9) & 1) << 5)); }
__host__ __device__ __forceinline__ void stage_rc(int b, int& R, int& C) { const int st = b / 1024, sb = b % 1024, swz = sb ^ (((sb >> 9) & 1) << 5); R = (st >> 1) * 16 + swz / 64; C = (st & 1) * 32 + (swz % 64) / 2; }
__host__ __device__ __forceinline__ int perm32(int rho) { const int n = rho >> 4, i = rho & 15; return 8 * (i >> 2) + 4 * n + (i & 3); }

struct Unit { int pm, pn; };
struct Gemm { const bf16_t* A; const bf16_t* Bt; int M, N, K, ld; };

struct StaticOrder {
    int nM, nN, nwg, G, c;
    __host__ __device__ void init(int M, int N, int G_, int c_) { nM = M / BM; nN = N / BM; nwg = nM * nN; G = G_; c = c_; }
    __host__ __device__ bool next(int i, Unit& u) const {
        const long L = (long)i * G + c; if (L >= nwg) return false;
        int wgid = (int)L; { const int q = nwg / NXCD, r = nwg % NXCD, xcd = wgid % NXCD, off = wgid / NXCD; wgid = (xcd < r ? xcd * (q + 1) : r * (q + 1) + (xcd - r) * q) + off; }
        const int nig = WGM * nN, gid = wgid / nig, fm = gid * WGM, gsz = (nM - fm) < WGM ? (nM - fm) : WGM;
        u.pm = fm + ((wgid % nig) % gsz); u.pn = (wgid % nig) / gsz; return true;
    }
    __device__ __forceinline__ void a_ready(const Unit&) const {}
    __device__ __forceinline__ void done(const Unit&) const {}
};
__device__ __forceinline__ unsigned cvt_pk_bf16(float lo, float hi) { unsigned r; asm volatile("v_cvt_pk_bf16_f32 %0, %1, %2" : "=v"(r) : "v"(lo), "v"(hi)); return r; }
typedef float f32x2 __attribute__((ext_vector_type(2)));
__device__ __forceinline__ f32x2 gelu_pk(f32x2 v) {
    const f32x2 av = __builtin_elementwise_abs(v), d = av * 0.2316418882f + 1.0f;
    f32x2 t; t.x = __builtin_amdgcn_rcpf(d.x); t.y = __builtin_amdgcn_rcpf(d.y);
    f32x2 q = t * 0.5307027145f + (-0.7265760135f); q = q * t + 0.7107068705f; q = q * t + (-0.142248368f); q = q * t + 0.127414796f; q = q * t;
    const f32x2 s = (v * v) * (-0.72134752044f);
    f32x2 e; e.x = __builtin_amdgcn_exp2f(s.x); e.y = __builtin_amdgcn_exp2f(s.y);
    const f32x2 m = v * (q * e), r = v - m;
    f32x2 o; o.x = v.x < 0.f ? m.x : r.x; o.y = v.y < 0.f ? m.y : r.y; return o;
}

struct EpiF32 {
    static constexpr bool PERM = false, AFTER_DRAIN = false;
    float* C; int ldc; const float* bias;
    __device__ __forceinline__ void operator()(const f32x4 (&acc)[2][2][4][2], const Unit& u, int wr, int wc, int fr, int fq) const {
        const int row0 = u.pm * BM + wr * 64 + fr, col0 = u.pn * BM + wc * 32 + 4 * fq;
        f32x4 bv[2][2];
#pragma unroll
        for (int bj = 0; bj < 2; ++bj)
#pragma unroll
            for (int n = 0; n < 2; ++n) bv[bj][n] = bias ? *(const f32x4*)(bias + col0 + bj * HALF + n * 16) : (f32x4){0.f, 0.f, 0.f, 0.f};
#pragma unroll
        for (int ai = 0; ai < 2; ++ai)
#pragma unroll
            for (int m = 0; m < 4; ++m) { float* rowp = C + (size_t)(row0 + ai * HALF + m * 16) * ldc + col0;
#pragma unroll
                for (int bj = 0; bj < 2; ++bj)
#pragma unroll
                    for (int n = 0; n < 2; ++n) *(f32x4*)(rowp + bj * HALF + n * 16) = acc[ai][bj][m][n] + bv[bj][n]; }
    }
};
template <int ACT  > struct EpiBf16 {
    static constexpr bool PERM = true, AFTER_DRAIN = false;
    bf16_t* O; int ldc; const float* bias; int split_cols; size_t split_stride;
    __device__ __forceinline__ void operator()(const f32x4 (&acc)[2][2][4][2], const Unit& u, int wr, int wc, int fr, int fq) const {
        const int row0 = u.pm * BM + wr * 64 + fr; int colt = u.pn * BM; bf16_t* base = O;
        if (split_cols) { const int t = colt / split_cols; base += (size_t)t * split_stride; colt -= t * split_cols; }
        const int col0 = colt + wc * 32 + 8 * fq, bcol0 = u.pn * BM + wc * 32 + 8 * fq;
        f32x4 bv[2][2];
#pragma unroll
        for (int bj = 0; bj < 2; ++bj)
#pragma unroll
            for (int n = 0; n < 2; ++n) bv[bj][n] = bias ? *(const f32x4*)(bias + bcol0 + bj * HALF + 4 * n) : (f32x4){0.f, 0.f, 0.f, 0.f};
#pragma unroll
        for (int ai = 0; ai < 2; ++ai)
#pragma unroll
            for (int m = 0; m < 4; ++m) { bf16_t* rowp = base + (size_t)(row0 + ai * HALF + m * 16) * ldc + col0;
#pragma unroll
                for (int bj = 0; bj < 2; ++bj) { f32x4 v0 = acc[ai][bj][m][0] + bv[bj][0], v1 = acc[ai][bj][m][1] + bv[bj][1];
                    if (ACT == 1) { f32x2 a = gelu_pk((f32x2){v0[0], v0[1]}), b = gelu_pk((f32x2){v0[2], v0[3]}), c = gelu_pk((f32x2){v1[0], v1[1]}), d = gelu_pk((f32x2){v1[2], v1[3]});
                        v0 = (f32x4){a.x, a.y, b.x, b.y}; v1 = (f32x4){c.x, c.y, d.x, d.y}; }
                    if (ACT == 2) {
#pragma unroll
                        for (int j = 0; j < 4; ++j) { v0[j] = 0.5f * v0[j] * (1.0f + erff(v0[j] * 0.70710678f)); v1[j] = 0.5f * v1[j] * (1.0f + erff(v1[j] * 0.70710678f)); } }
                    u32x4 w; w.x = cvt_pk_bf16(v0[0], v0[1]); w.y = cvt_pk_bf16(v0[2], v0[3]); w.z = cvt_pk_bf16(v1[0], v1[1]); w.w = cvt_pk_bf16(v1[2], v1[3]);
                    *(u32x4*)(rowp + bj * HALF) = w; } }
    }
};

template <class Epi, class Sched, bool STAMP = false>
__device__ __forceinline__ void gemm_phase(PG8_LAS unsigned char* lds, const Gemm g, const Sched& S, const Epi& E, unsigned long long* stamps) {
    int tid_raw = threadIdx.x; asm volatile("" : "+v"(tid_raw));
    const int tid = tid_raw, wid = __builtin_amdgcn_readfirstlane(tid >> 6), lane = tid & 63, wr = wid >> 2, wc = wid & 3, fr = lane & 15, fq = lane >> 4;
    const int K = g.K, nt = K / BK, LD = g.ld ? g.ld : K;
    int ts_lo = 0, ts_hi = 0, nts = 0; const unsigned long long rt_entry = STAMP ? (unsigned long long)wall_clock64() : 0ull;
#define PG8_STAMP() do { if (STAMP && wid == 0 && nts < 64) { const unsigned long long _c = (unsigned long long)clock64(); \
        ts_lo = (lane == nts) ? (int)(unsigned)_c : ts_lo; ts_hi = (lane == nts) ? (int)(unsigned)(_c >> 32) : ts_hi; ++nts; } } while (0)
    PG8_STAMP();
    unsigned voffA[2], voffB[2];
#pragma unroll
    for (int i = 0; i < 2; ++i) { int R, C; stage_rc(tid * 16 + i * 8192, R, C); const int Rb = Epi::PERM ? ((R & ~31) + perm32(R & 31)) : R;
        voffA[i] = (unsigned)(R * LD + C) * 2u; voffB[i] = (unsigned)(Rb * LD + C) * 2u; }
    const size_t kstep = (size_t)(BK * 2);
    const size_t hstep = (size_t)HALF * LD * 2;
    const size_t tstep = 2 * hstep;
    const unsigned ldsw = (unsigned)wid * 1024u;
    const int aoff = lds_byte(wr * 64 + fr, fq * 8), boff = lds_byte(wc * 32 + fr, fq * 8);
#define PG8_SA(b, h) (((b) * 2 + (h)) * HTB)
#define PG8_SB(b, h) ((4 + (b) * 2 + (h)) * HTB)
#define PG8_STAGE(bufoff, gbase, voff) do { _Pragma("unroll") for (int _i = 0; _i < 2; ++_i) \
        __builtin_amdgcn_global_load_lds((const unsigned*)((const char*)(gbase) + (voff)[_i]), (PG8_LAS unsigned*)(lds + (bufoff) + ldsw + _i * 8192), 16, 0, 0); } while (0)
#define PG8_LDA(dst, b, h) do { _Pragma("unroll") for (int m = 0; m < 4; ++m) _Pragma("unroll") for (int k = 0; k < 2; ++k) dst[m][k] = *(const PG8_LAS bf16x8*)(lds + PG8_SA(b, h) + aoff + m * 2048 + k * 1024); } while (0)
#define PG8_LDB(dst, b, h) do { _Pragma("unroll") for (int n = 0; n < 2; ++n) _Pragma("unroll") for (int k = 0; k < 2; ++k) dst[n][k] = *(const PG8_LAS bf16x8*)(lds + PG8_SB(b, h) + boff + n * 2048 + k * 1024); } while (0)
#define PG8_MMA(ai, bj, At, Bt) do { __builtin_amdgcn_s_setprio(1); _Pragma("unroll") for (int m = 0; m < 4; ++m) _Pragma("unroll") for (int n = 0; n < 2; ++n) _Pragma("unroll") for (int k = 0; k < 2; ++k) \
        acc[ai][bj][m][n] = __builtin_amdgcn_mfma_f32_16x16x32_bf16(Bt[n][k], At[m][k], acc[ai][bj][m][n], 0, 0, 0); __builtin_amdgcn_s_setprio(0); } while (0)
#define PG8_WAIT_V(n) asm volatile("s_waitcnt vmcnt(" #n ")" ::: "memory")
#define PG8_WAIT_L(n) asm volatile("s_waitcnt lgkmcnt(" #n ")" ::: "memory")
#define PG8_BAR __builtin_amdgcn_s_barrier()
#define PG8_SCHED __builtin_amdgcn_sched_barrier(0)
    Unit cur, nxt; int ui = 0;
    if (!S.next(0, cur)) return;
    f32x4 acc[2][2][4][2];
#pragma unroll
    for (int a = 0; a < 2; ++a)
#pragma unroll
        for (int b = 0; b < 2; ++b)
#pragma unroll
            for (int m = 0; m < 4; ++m)
#pragma unroll
                for (int n = 0; n < 2; ++n) acc[a][b][m][n] = (f32x4){0.f, 0.f, 0.f, 0.f};
    bf16x8 At[4][2], B0[2][2], B1[2][2];
    const char* cA = (const char*)g.A + (size_t)cur.pm * tstep; const char* cB = (const char*)g.Bt + (size_t)cur.pn * tstep;
    S.a_ready(cur);
    PG8_STAGE(PG8_SB(0, 0), cB, voffB); PG8_STAGE(PG8_SA(0, 0), cA, voffA); PG8_STAGE(PG8_SB(0, 1), cB + hstep, voffB); PG8_STAGE(PG8_SA(0, 1), cA + hstep, voffA);
    if (wr == 1) PG8_BAR;
    PG8_WAIT_V(4); PG8_BAR;
    PG8_STAGE(PG8_SB(1, 0), cB + kstep, voffB); PG8_STAGE(PG8_SA(1, 0), cA + kstep, voffA); PG8_STAGE(PG8_SB(1, 1), cB + hstep + kstep, voffB);
    PG8_WAIT_V(6); PG8_BAR;
    PG8_STAMP();
    for (;;) {
        const bool has_next = S.next(ui + 1, nxt);
        const char* nA = has_next ? (const char*)g.A + (size_t)nxt.pm * tstep : cA; const char* nB = has_next ? (const char*)g.Bt + (size_t)nxt.pn * tstep : cB;
        for (int t = 0; t < nt; t += 2) {
            const bool last = (t == nt - 2);
            const char* a1 = cA + (size_t)(t + 1) * kstep;
            const char* a2 = last ? nA : cA + (size_t)(t + 2) * kstep; const char* b2 = last ? nB : cB + (size_t)(t + 2) * kstep;
            const char* a3 = a2 + kstep; const char* b3 = b2 + kstep;
            if (last && has_next) S.a_ready(nxt);
            PG8_LDB(B0, 0, 0); PG8_SCHED; PG8_LDA(At, 0, 0); PG8_STAGE(PG8_SA(1, 1), a1 + hstep, voffA);
            PG8_WAIT_L(8); PG8_BAR; PG8_WAIT_L(0); PG8_MMA(0, 0, At, B0); PG8_BAR; PG8_SCHED;
            PG8_LDB(B1, 0, 1); PG8_STAGE(PG8_SB(0, 0), b2, voffB);
            PG8_BAR; PG8_WAIT_L(0); PG8_MMA(0, 1, At, B1); PG8_BAR;
            PG8_LDA(At, 0, 1); PG8_STAGE(PG8_SA(0, 0), a2, voffA);
            PG8_BAR; PG8_WAIT_L(0); PG8_MMA(1, 0, At, B0); PG8_BAR; PG8_SCHED;
            PG8_STAGE(PG8_SB(0, 1), b2 + hstep, voffB);
            PG8_WAIT_V(6); PG8_BAR; PG8_MMA(1, 1, At, B1); PG8_BAR;
            PG8_LDB(B0, 1, 0); PG8_SCHED; PG8_LDA(At, 1, 0); PG8_STAGE(PG8_SA(0, 1), a2 + hstep, voffA);
            PG8_WAIT_L(8); PG8_BAR; PG8_WAIT_L(0); PG8_MMA(0, 0, At, B0); PG8_BAR; PG8_SCHED;
            PG8_LDB(B1, 1, 1); PG8_STAGE(PG8_SB(1, 0), b3, voffB);
            PG8_BAR; PG8_WAIT_L(0); PG8_MMA(0, 1, At, B1); PG8_BAR;
            PG8_LDA(At, 1, 1); PG8_STAGE(PG8_SA(1, 0), a3, voffA);
            PG8_BAR; PG8_WAIT_L(0); PG8_MMA(1, 0, At, B0); PG8_BAR; PG8_SCHED;
            PG8_STAGE(PG8_SB(1, 1), b3 + hstep, voffB);
            PG8_WAIT_V(6); PG8_BAR; PG8_MMA(1, 1, At, B1); PG8_BAR;
        }
        PG8_STAMP();
        if constexpr (!Epi::AFTER_DRAIN) { E(acc, cur, wr, wc, fr, fq); S.done(cur); }
        PG8_STAMP();
        if (!has_next) break;
#pragma unroll
        for (int a = 0; a < 2; ++a)
#pragma unroll
            for (int b = 0; b < 2; ++b)
#pragma unroll
                for (int m = 0; m < 4; ++m)
#pragma unroll
                    for (int n = 0; n < 2; ++n) acc[a][b][m][n] = (f32x4){0.f, 0.f, 0.f, 0.f};
        cur = nxt; cA = nA; cB = nB; ++ui;
    }
    PG8_WAIT_V(0);
    if (wr == 0) PG8_BAR;
    PG8_BAR;
    if constexpr (Epi::AFTER_DRAIN) { E.fused(acc, cur, wr, wc, fr, fq, lds, wid, lane); S.done(cur); }
    PG8_STAMP();
    if (STAMP && wid == 0) { stamps[lane] = lane < nts ? (((unsigned long long)(unsigned)ts_hi << 32) | (unsigned)ts_lo) : 0ull;
        if (lane == 62) stamps[62] = rt_entry; if (lane == 63) stamps[63] = (unsigned long long)wall_clock64(); }
#undef PG8_STAMP
#undef PG8_SA
#undef PG8_SB
#undef PG8_STAGE
#undef PG8_LDA
#undef PG8_LDB
#undef PG8_MMA
#undef PG8_WAIT_V
#undef PG8_WAIT_L
#undef PG8_BAR
#undef PG8_SCHED
}
}
namespace mk {
using pg8::bf16_t; using pg8::bf16x8; using pg8::f32x4; using pg8::u32x4;
typedef unsigned u32x2 __attribute__((ext_vector_type(2)));
typedef LAS unsigned char* ldsp;

constexpr int DM = 1024, NB = 8, SEQ = 4096, CTX = 256, TB = SEQ + CTX, T = NB * TB, HT = T / 2, DFF = 2816, INNER = 2048;
constexpr int CH = 128, NCH = TB / CH;
constexpr int NWAVES = 8, NTH = 512;
constexpr float EPS = 1e-6f;
constexpr size_t MiB = 1u << 20;
constexpr size_t WS_CTL = 0, CTL_ZERO_BYTES = 128 * 1024;
constexpr size_t WS_MOD = 1 * MiB;
constexpr size_t WS_WG = 1 * MiB + 768 * 1024;
constexpr size_t WS_WQT = 1 * MiB + 960 * 1024, WS_WKT = WS_WQT + 16384;
constexpr size_t WS_GATES = 2 * MiB;
constexpr size_t WS_DT = 3 * MiB + 512 * 1024;
constexpr size_t WS_W = 8 * MiB;
constexpr size_t WS_CTXS = 58 * MiB;
constexpr size_t WS_H = 66 * MiB;
constexpr size_t WS_Y = 134 * MiB;
constexpr size_t WS_BIG = 202 * MiB;
constexpr size_t SLOT = 68 * MiB;
constexpr size_t WS_SSQ = 474 * MiB;
constexpr size_t WS_END = 480 * MiB;
constexpr size_t WO_GU1 = 0, WO_D1 = WO_GU1 + (size_t)2 * DFF * DM, WO_IN = WO_D1 + (size_t)DM * DFF, WO_OUT = WO_IN + (size_t)6400 * DM,
                 WO_GU2 = WO_OUT + (size_t)DM * INNER, WO_D2 = WO_GU2 + (size_t)2 * DFF * DM, WO_END = WO_D2 + (size_t)DM * DFF;
static_assert(WS_W + WO_END * 2 <= WS_CTXS && WS_BIG + 4 * SLOT == WS_SSQ && WS_SSQ + (size_t)T * 32 * 4 <= WS_END && (size_t)HT * INNER * 2 == SLOT && (size_t)T * DFF * 2 <= 4 * SLOT, "d_ws map");
static_assert(WS_GATES + (size_t)HT * 16 * 4 <= WS_DT && WS_DT + (size_t)HT * 64 * 4 <= WS_W && WS_MOD + 2 * 9 * 9216 * 4 <= WS_WG && WS_WG + 16 * 6144 * 2 <= WS_WQT && WS_WKT + 16384 <= WS_GATES, "d_ws map small");
constexpr int LDS_BYTES = 155648;
constexpr int LDS_XB = LDS_BYTES - 16;

typedef __bf16 bf16v2 __attribute__((ext_vector_type(2)));
typedef float f32v2 __attribute__((ext_vector_type(2)));
__device__ __forceinline__ unsigned pk_bf16(float lo, float hi) { const bf16v2 v = __builtin_convertvector((f32v2){lo, hi}, bf16v2); return __builtin_bit_cast(unsigned, v); }
__device__ __forceinline__ unsigned cvt_pk_bf16(float lo, float hi) { return pk_bf16(lo, hi); }
__device__ __forceinline__ float bflo(unsigned w) { return __uint_as_float(w << 16); }
__device__ __forceinline__ float bfhi(unsigned w) { return __uint_as_float(w & 0xffff0000u); }
__device__ __forceinline__ float bf1(unsigned short h) { return __uint_as_float(((unsigned)h) << 16); }
__device__ __forceinline__ unsigned short f2bf(float f) { return (unsigned short)(cvt_pk_bf16(f, 0.f) & 0xffffu); }
__device__ __forceinline__ float silu_f(float x) { return x * __builtin_amdgcn_rcpf(1.f + __expf(-x)); }
__device__ __forceinline__ float softplus_f(float x) { return fmaxf(x, 0.f) + log1pf(__expf(-fabsf(x))); }
__device__ __forceinline__ float wave_sum(float v) {
#pragma unroll
    for (int o = 1; o < 64; o <<= 1) v += __shfl_xor(v, o);
    return v;
}
__device__ __forceinline__ void unpack8(const u32x4 w, float (&f)[8]) {
    f[0] = bflo(w.x); f[1] = bfhi(w.x); f[2] = bflo(w.y); f[3] = bfhi(w.y); f[4] = bflo(w.z); f[5] = bfhi(w.z); f[6] = bflo(w.w); f[7] = bfhi(w.w);
}
__device__ __forceinline__ u32x4 pack8(const float (&f)[8]) {
    u32x4 w; w.x = cvt_pk_bf16(f[0], f[1]); w.y = cvt_pk_bf16(f[2], f[3]); w.z = cvt_pk_bf16(f[4], f[5]); w.w = cvt_pk_bf16(f[6], f[7]); return w;
}
template <int MI, int NI, int KS>
__device__ __forceinline__ void wmma(f32x4 (&acc)[MI][NI], const LAS bf16_t* A, int lda, const LAS bf16_t* B, int ldb, int lane) {
    const int r = lane & 15, kq = lane >> 4;
#pragma unroll
    for (int ks = 0; ks < KS; ++ks) {
        bf16x8 a[MI], b[NI];
#pragma unroll
        for (int mi = 0; mi < MI; ++mi) a[mi] = *(const LAS bf16x8*)(A + (mi * 16 + r) * lda + ks * 32 + kq * 8);
#pragma unroll
        for (int ni = 0; ni < NI; ++ni) b[ni] = *(const LAS bf16x8*)(B + (ni * 16 + r) * ldb + ks * 32 + kq * 8);
#pragma unroll
        for (int mi = 0; mi < MI; ++mi)
#pragma unroll
            for (int ni = 0; ni < NI; ++ni) acc[mi][ni] = __builtin_amdgcn_mfma_f32_16x16x32_bf16(a[mi], b[ni], acc[mi][ni], 0, 0, 0);
    }
}

struct Args { const float* in[29]; float* out; unsigned char* ws; int ph_lo, ph_hi; };

struct LatentOrder : pg8::StaticOrder {
    __device__ bool next(int i, pg8::Unit& u) const { if (!pg8::StaticOrder::next(i, u)) return false; u.pm = (u.pm >> 4) * 17 + 1 + (u.pm & 15); return true; }
};
struct CtxOrder {
    int pm, pn; bool has;
    __device__ void init(int npan, int nN, int c) { has = c < npan * nN; pm = (c % npan) * 17; pn = c / npan; }
    __device__ bool next(int i, pg8::Unit& u) const { if (i > 0 || !has) return false; u.pm = pm; u.pn = pn; return true; }
    __device__ __forceinline__ void a_ready(const pg8::Unit&) const {}
    __device__ __forceinline__ void done(const pg8::Unit&) const {}
};
struct EpiSwiglu {
    static constexpr bool PERM = true, AFTER_DRAIN = false;
    bf16_t* O; int ldc;
    __device__ __forceinline__ void operator()(const f32x4 (&acc)[2][2][4][2], const pg8::Unit& u, int wr, int wc, int fr, int fq) const {
        const int row0 = u.pm * 256 + wr * 64 + fr, col0 = u.pn * 128 + wc * 32 + 8 * fq;
#pragma unroll
        for (int ai = 0; ai < 2; ++ai)
#pragma unroll
            for (int m = 0; m < 4; ++m) {
                float v[8];
#pragma unroll
                for (int n = 0; n < 2; ++n)
#pragma unroll
                    for (int j = 0; j < 4; ++j) v[n * 4 + j] = silu_f(acc[ai][0][m][n][j]) * acc[ai][1][m][n][j];
                *(u32x4*)(O + (size_t)(row0 + ai * 128 + m * 16) * ldc + col0) = pack8(v);
            }
    }
};
template <bool TWO> struct EpiMulSilu {
    static constexpr bool PERM = true, AFTER_DRAIN = false;
    bf16_t* R; const bf16_t* R2; int ldc; float* ssq;
    __device__ __forceinline__ void operator()(const f32x4 (&acc)[2][2][4][2], const pg8::Unit& u, int wr, int wc, int fr, int fq) const {
        const int row0 = u.pm * 256 + wr * 64 + fr, col0 = u.pn * 256 + wc * 32 + 8 * fq;
#pragma unroll
        for (int ai = 0; ai < 2; ++ai)
#pragma unroll
            for (int m = 0; m < 4; ++m) {
                float sq = 0.f;
#pragma unroll
                for (int bj = 0; bj < 2; ++bj) {
                    const size_t o = (size_t)(row0 + ai * 128 + m * 16) * ldc + col0 + bj * 128;
                    float r[8]; unpack8(*(const u32x4*)(R + o), r);
                    if (TWO) { float r2[8]; unpack8(*(const u32x4*)(R2 + o), r2);
#pragma unroll
                        for (int j = 0; j < 8; ++j) r[j] += r2[j]; }
#pragma unroll
                    for (int n = 0; n < 2; ++n)
#pragma unroll
                        for (int j = 0; j < 4; ++j) r[n * 4 + j] *= silu_f(acc[ai][bj][m][n][j]);
                    *(u32x4*)(R + o) = pack8(r);
                    if (TWO) {
#pragma unroll
                        for (int j = 0; j < 8; ++j) sq += r[j] * r[j]; }
                }
                if (TWO) { sq += __shfl_xor(sq, 16); sq += __shfl_xor(sq, 32); if (fq == 0) ssq[(size_t)(row0 + ai * 128 + m * 16) * 32 + u.pn * 4 + wc] = sq; }
            }
    }
};
struct EpiSsdIn {
    static constexpr bool PERM = true, AFTER_DRAIN = false;
    bf16_t* X; float* DT;
    __device__ __forceinline__ void operator()(const f32x4 (&acc)[2][2][4][2], const pg8::Unit& u, int wr, int wc, int fr, int fq) const {
        const int row0 = u.pm * 256 + wr * 64 + fr;
        if (u.pn < 16) {
            const int col0 = u.pn * 256 + wc * 32 + 8 * fq;
#pragma unroll
            for (int ai = 0; ai < 2; ++ai)
#pragma unroll
                for (int m = 0; m < 4; ++m)
#pragma unroll
                    for (int bj = 0; bj < 2; ++bj) {
                        u32x4 w; const f32x4 v0 = acc[ai][bj][m][0], v1 = acc[ai][bj][m][1];
                        w.x = cvt_pk_bf16(v0[0], v0[1]); w.y = cvt_pk_bf16(v0[2], v0[3]); w.z = cvt_pk_bf16(v1[0], v1[1]); w.w = cvt_pk_bf16(v1[2], v1[3]);
                        *(u32x4*)(X + (size_t)(row0 + ai * 128 + m * 16) * 4096 + col0 + bj * 128) = w;
                    }
        } else if (wc < 2) {
            const int col0 = wc * 32 + 8 * fq;
#pragma unroll
            for (int ai = 0; ai < 2; ++ai)
#pragma unroll
                for (int m = 0; m < 4; ++m) {
                    float* p = DT + (size_t)(row0 + ai * 128 + m * 16) * 64 + col0;
                    *(f32x4*)p = acc[ai][0][m][0]; *(f32x4*)(p + 4) = acc[ai][0][m][1];
                }
        }
    }
};

__device__ __forceinline__ void tr_item(const float* W, int ldw, int K, bf16_t* WT, int k0, int n0, int drow0, LAS float* scr, int lane, const float* kscale) {
#pragma unroll 8
    for (int i = 0; i < 32; ++i) { const int kk = 2 * i + (lane >> 5); scr[kk * 33 + (lane & 31)] = W[(size_t)(k0 + kk) * ldw + n0 + (lane & 31)] * (kscale ? kscale[k0 + kk] : 1.f); }
    asm volatile("s_waitcnt lgkmcnt(0)" ::: "memory");
    const int c = lane & 7;
#pragma unroll
    for (int j = 0; j < 4; ++j) { const int n = (lane >> 3) + 8 * j; const LAS float* s = scr + (8 * c) * 33 + n;
        u32x4 o; o.x = cvt_pk_bf16(s[0 * 33], s[1 * 33]); o.y = cvt_pk_bf16(s[2 * 33], s[3 * 33]); o.z = cvt_pk_bf16(s[4 * 33], s[5 * 33]); o.w = cvt_pk_bf16(s[6 * 33], s[7 * 33]);
        *(u32x4*)(WT + (size_t)(drow0 + n) * K + k0 + 8 * c) = o; }
    asm volatile("s_waitcnt lgkmcnt(0)" ::: "memory");
}
__device__ __forceinline__ void convert_layer(const Args& a, int layer, ldsp lds, int gw, int NGW, int wave, int lane) {
    LAS float* scr = (LAS float*)(lds + wave * 16384);
    bf16_t* W = (bf16_t*)(a.ws + WS_W);
    const float* wg0 = a.in[7] + (size_t)(layer * 2 + 0) * DM * DFF; const float* wu0 = a.in[8] + (size_t)(layer * 2 + 0) * DM * DFF; const float* wd0 = a.in[9] + (size_t)(layer * 2 + 0) * DFF * DM;
    const float* wg1 = a.in[7] + (size_t)(layer * 2 + 1) * DM * DFF; const float* wu1 = a.in[8] + (size_t)(layer * 2 + 1) * DM * DFF; const float* wd1 = a.in[9] + (size_t)(layer * 2 + 1) * DFF * DM;
    const float* win = layer == 0 ? a.in[10] : a.in[21]; const int nin = layer == 0 ? 4096 : 6208;
    const float* wout = layer == 0 ? a.in[20] : a.in[28];
    const int total = 4 * 16 * 88 + 2 * 44 * 32 + 16 * (nin / 32) + 32 * 32;
#define MK_TRJOB(src, ldw, K, N, dst, mode, ksc) { const int nb_ = (N) / 32, ni_ = ((K) / 64) * nb_; if (r >= 0 && r < ni_) { const int kb_ = r / nb_, n0_ = (r % nb_) * 32; \
        const int d0_ = (mode) == 0 ? n0_ : 256 * (n0_ / 128) + (n0_ % 128) + ((mode) == 2 ? 128 : 0); tr_item(src, ldw, K, dst, kb_ * 64, n0_, d0_, scr, lane, ksc); } r -= ni_; }
    for (int it = gw; it < total; it += NGW) {
        int r = it;
        MK_TRJOB(wg0, DFF, DM, DFF, W + WO_GU1, 1, nullptr)
        MK_TRJOB(wu0, DFF, DM, DFF, W + WO_GU1, 2, nullptr)
        MK_TRJOB(wg1, DFF, DM, DFF, W + WO_GU2, 1, nullptr)
        MK_TRJOB(wu1, DFF, DM, DFF, W + WO_GU2, 2, nullptr)
        MK_TRJOB(wd0, DM, DFF, DM, W + WO_D1, 0, nullptr)
        MK_TRJOB(wd1, DM, DFF, DM, W + WO_D2, 0, nullptr)
        MK_TRJOB(win, nin, DM, nin, W + WO_IN, 0, nullptr)
        MK_TRJOB(wout, DM, INNER, DM, W + WO_OUT, 0, (layer == 1 ? a.in[27] : nullptr))
    }
#undef MK_TRJOB
    if (layer == 1) {
        u32x4* z = (u32x4*)(W + WO_IN + (size_t)6208 * DM);
        for (int i = gw * 64 + lane; i < 192 * DM / 8; i += NGW * 64) z[i] = (u32x4){0u, 0u, 0u, 0u};
    }
}
__device__ __forceinline__ void mods_phase(const Args& a, ldsp lds, int blk, int G, int tid) {
    LAS float* sv = (LAS float*)lds;
    LAS float* red = (LAS float*)(lds + 40960);
    float* mod = (float*)(a.ws + WS_MOD);
    for (int i = tid; i < 9 * DM; i += NTH) { const int v = i >> 10, k = i & 1023; sv[i] = silu_f(v < 8 ? a.in[1][v * DM + k] : a.in[3][k]); }
    __syncthreads();
    const int col = tid & 63, ks = tid >> 6;
    for (int u = blk; u < 2 * 144; u += G) {
        const int layer = u / 144, n0 = (u % 144) * 64;
        const float* W = a.in[4] + (size_t)layer * DM * 9216 + n0 + col;
        float acc[9];
#pragma unroll
        for (int v = 0; v < 9; ++v) acc[v] = 0.f;
#pragma unroll 8
        for (int k = ks * 128; k < ks * 128 + 128; ++k) { const float w = W[(size_t)k * 9216];
#pragma unroll
            for (int v = 0; v < 9; ++v) acc[v] += sv[v * DM + k] * w; }
#pragma unroll
        for (int v = 0; v < 9; ++v) red[(ks * 9 + v) * 64 + col] = acc[v];
        __syncthreads();
        for (int o = tid; o < 9 * 64; o += NTH) { const int v = o >> 6, cc = o & 63; float s = a.in[5][layer * 9216 + n0 + cc];
#pragma unroll
            for (int q = 0; q < 8; ++q) s += red[(q * 9 + v) * 64 + cc];
            mod[(size_t)(layer * 9 + v) * 9216 + n0 + cc] = s; }
        __syncthreads();
    }
    { bf16_t* wqt = (bf16_t*)(a.ws + WS_WQT); bf16_t* wkt = (bf16_t*)(a.ws + WS_WKT);
      for (int i = blk * NTH + tid; i < 8192; i += G * NTH) { const int bk = i >> 4, j = (i >> 2) & 3, k = i & 3;
          wqt[i] = f2bf(a.in[13][bk * 16 + k * 4 + j]); wkt[i] = f2bf(a.in[14][bk * 16 + k * 4 + j] * 0.04419417382415922f); } }
    {
        bf16_t* gt = (bf16_t*)(a.ws + WS_WG); const float* wq = a.in[13]; const float* wk = a.in[14]; const float* wv = a.in[15]; const float* wg = a.in[16];
        for (int i = blk * NTH + tid; i < 16 * INNER; i += G * NTH) { const int g = i >> 11, ch = i & 2047, bk = ch >> 2, c = ch & 3;
            float sqk = 0.f, sv = 0.f;
#pragma unroll
            for (int d = 0; d < 4; ++d) { sqk += wq[bk * 16 + c * 4 + d] * wg[(size_t)(4 * bk + d) * 16 + g] + wk[bk * 16 + c * 4 + d] * wg[(size_t)(INNER + 4 * bk + d) * 16 + g];
                sv += wv[bk * 16 + c * 4 + d] * wg[(size_t)(2 * INNER + 4 * bk + d) * 16 + g]; }
            gt[g * 4096 + ch] = f2bf(sqk); gt[g * 4096 + INNER + ch] = f2bf(sv); }
    }
}

__device__ __forceinline__ void rows_phase(const float* xs_lat, const float* xs_ctx, float* xd_lat, float* xd_ctx, const bf16_t* yp, const float* ypart, const float* gpost, const float* modg, int jgate, float coef,
                                           bf16_t* hp, const float* gnext, const float* modn, int jshift, int mode, int b0, int b1, int src_bf, int dst_bf, int blk, int G, int wave, int lane) {
    const bool has_y = yp != nullptr, has_h = hp != nullptr, has_xd = xd_lat != nullptr;
    const int per = mode == 1 ? SEQ : mode == 2 ? CTX : TB, toff = mode == 1 ? CTX : 0, nitems = (b1 - b0) * per;
    const int NW = G * NWAVES, RPW = (nitems + NW - 1) / NW; int i_lo = (blk * NWAVES + wave) * RPW; if (i_lo > nitems) i_lo = nitems; const int i_hi = (i_lo + RPW < nitems) ? i_lo + RPW : nitems;
    int b = b0 + i_lo / per, t = toff + i_lo % per;
    int key = -1;
    f32x4 gate[4], gp[4], gn[4], sh[4], sc[4];
#pragma unroll
    for (int j = 0; j < 4; ++j) { gate[j] = gp[j] = gn[j] = sh[j] = sc[j] = (f32x4){0.f, 0.f, 0.f, 0.f}; }
#pragma unroll 2
    for (int it = i_lo; it < i_hi; ++it) {
        const int R = b * TB + t; const bool isctx = t < CTX;
        const int v = isctx ? 8 : b;
        if (v != key) { key = v;
#pragma unroll
            for (int j = 0; j < 4; ++j) { const int col = 256 * j + 4 * lane;
                if (has_y) { gate[j] = *(const f32x4*)(modg + (size_t)(v * 9 + jgate) * DM + col); gp[j] = *(const f32x4*)(gpost + col); }
                if (has_h) { gn[j] = *(const f32x4*)(gnext + col); sh[j] = *(const f32x4*)(modn + (size_t)(v * 9 + jshift) * DM + col); sc[j] = *(const f32x4*)(modn + (size_t)(v * 9 + jshift + 1) * DM + col); } } }
        const size_t xo = isctx ? ((size_t)b * CTX + t) * DM : ((size_t)b * SEQ + (t - CTX)) * DM;
        const float* xs = (isctx ? xs_ctx : xs_lat) + xo;
        f32x4 x[4];
        if (src_bf) {
#pragma unroll
            for (int j = 0; j < 4; ++j) { const u32x2 w = *(const u32x2*)((const bf16_t*)xs + 256 * j + 4 * lane); x[j] = (f32x4){bflo(w.x), bfhi(w.x), bflo(w.y), bfhi(w.y)}; }
        } else {
#pragma unroll
            for (int j = 0; j < 4; ++j) x[j] = *(const f32x4*)(xs + 256 * j + 4 * lane);
        }
        if (has_y) {
            f32x4 yv[4]; float ss = 0.f;
            float ysc = 1.f;
            if (ypart != nullptr) ysc = rsqrtf(wave_sum(lane < 32 ? ypart[(size_t)R * 32 + lane] : 0.f) * (1.f / INNER) + EPS);
#pragma unroll
            for (int j = 0; j < 4; ++j) { const u32x2 w = *(const u32x2*)(yp + (size_t)R * DM + 256 * j + 4 * lane); yv[j] = (f32x4){bflo(w.x), bfhi(w.x), bflo(w.y), bfhi(w.y)} * ysc;
                ss += (yv[j][0] * yv[j][0] + yv[j][1] * yv[j][1]) + (yv[j][2] * yv[j][2] + yv[j][3] * yv[j][3]); }
            const float rstd = rsqrtf(wave_sum(ss) * (1.f / DM) + EPS);
#pragma unroll
            for (int j = 0; j < 4; ++j) x[j] += coef * gate[j] * (yv[j] * rstd * gp[j]);
        }
        if (has_xd) { float* xd = (isctx ? xd_ctx : xd_lat) + xo;
            if (dst_bf) {
#pragma unroll
                for (int j = 0; j < 4; ++j) { u32x2 w; w.x = cvt_pk_bf16(x[j][0], x[j][1]); w.y = cvt_pk_bf16(x[j][2], x[j][3]); *(u32x2*)((bf16_t*)xd + 256 * j + 4 * lane) = w; }
            } else {
#pragma unroll
                for (int j = 0; j < 4; ++j) *(f32x4*)(xd + 256 * j + 4 * lane) = x[j];
            } }
        if (has_h) {
            float ss = 0.f;
#pragma unroll
            for (int j = 0; j < 4; ++j) ss += (x[j][0] * x[j][0] + x[j][1] * x[j][1]) + (x[j][2] * x[j][2] + x[j][3] * x[j][3]);
            const float rstd = rsqrtf(wave_sum(ss) * (1.f / DM) + EPS);
#pragma unroll
            for (int j = 0; j < 4; ++j) { const f32x4 hv = (x[j] * rstd * gn[j]) * (sc[j] + 1.f) + sh[j];
                u32x2 w; w.x = cvt_pk_bf16(hv[0], hv[1]); w.y = cvt_pk_bf16(hv[2], hv[3]); *(u32x2*)(hp + (size_t)R * DM + 256 * j + 4 * lane) = w; }
        }
        if (++t == toff + per) { t = toff; ++b; }
    }
}
__device__ __forceinline__ void conv_seg(int t, int& lo, int& hi) { if (t < CTX) { lo = 0; hi = CTX; } else { lo = CTX + ((t - CTX) >> 6) * 64; hi = lo + 64; } }
__device__ __forceinline__ int chunk_of_step(int dir, int step) { return dir == 0 ? step : (step < 2 ? 1 - step : NCH + 1 - step); }

__device__ __forceinline__ void mlstm_prep(const Args& a, ldsp lds, int blk, int G, int tid, int wave, int lane) {
    const bf16_t* XM = (const bf16_t*)(a.ws + WS_BIG); bf16_t* XC = (bf16_t*)(a.ws + WS_BIG + SLOT); bf16_t* V = (bf16_t*)(a.ws + WS_BIG + 2 * SLOT);
    float* GT = (float*)(a.ws + WS_GATES); const bf16_t* GW = (const bf16_t*)(a.ws + WS_WG);
    const float* conv_w = a.in[11]; const float* conv_b = a.in[12]; const float* wv = a.in[15]; const float* bg = a.in[17];
    constexpr int RS = 4112;
    const ldsp XCT = lds + 82432;
    LAS float* red = (LAS float*)lds;
    static_assert(82432 + 16 * 4112 <= LDS_XB, "LDS map of the mLSTM prep phase");
    const int r16 = lane & 15, kq = lane >> 4, ch = 4 * tid;
    f32x4 cw[5], wvb[4]; const f32x4 cbv = *(const f32x4*)(conv_b + ch);
#pragma unroll
    for (int d = 0; d < 5; ++d) cw[d] = *(const f32x4*)(conv_w + d * INNER + ch);
#pragma unroll
    for (int c = 0; c < 4; ++c) wvb[c] = *(const f32x4*)(wv + tid * 16 + 4 * c);
    for (int u = blk; u < HT / 16; u += G) {
        const int r0 = u * 16, t0 = r0 % TB; int slo, shi; conv_seg(t0, slo, shi);
        for (int i = tid; i < 20 * 256; i += NTH) { const int rr = i >> 8, c16 = i & 255, t = t0 - 2 + rr;
            u32x4 val = {0u, 0u, 0u, 0u}; if (t >= slo && t < shi) val = *(const u32x4*)(XM + (size_t)(r0 - 2 + rr) * INNER + c16 * 8);
            *(LAS u32x4*)(lds + rr * RS + c16 * 16) = val; }
        __syncthreads();
        {
            f32x4 win[5];
#pragma unroll
            for (int d = 0; d < 4; ++d) { const u32x2 w = *(const LAS u32x2*)(lds + d * RS + ch * 2); win[d] = (f32x4){bflo(w.x), bfhi(w.x), bflo(w.y), bfhi(w.y)}; }
#pragma unroll
            for (int tt = 0; tt < 16; ++tt) {
                { const u32x2 w = *(const LAS u32x2*)(lds + (tt + 4) * RS + ch * 2); win[4] = (f32x4){bflo(w.x), bfhi(w.x), bflo(w.y), bfhi(w.y)}; }
                f32x4 sacc = cbv;
#pragma unroll
                for (int d = 0; d < 5; ++d) sacc += cw[d] * win[d];
                const f32x4 xc = {silu_f(sacc[0]), silu_f(sacc[1]), silu_f(sacc[2]), silu_f(sacc[3])};
                const f32x4 vv = win[2][0] * wvb[0] + win[2][1] * wvb[1] + win[2][2] * wvb[2] + win[2][3] * wvb[3];
                u32x2 xw, vw; xw.x = pk_bf16(xc[0], xc[1]); xw.y = pk_bf16(xc[2], xc[3]); vw.x = pk_bf16(vv[0], vv[1]); vw.y = pk_bf16(vv[2], vv[3]);
                *(u32x2*)(XC + (size_t)(r0 + tt) * INNER + ch) = xw; *(u32x2*)(V + (size_t)(r0 + tt) * INNER + ch) = vw;
                *(LAS u32x2*)(XCT + tt * RS + ch * 2) = xw;
#pragma unroll
                for (int d = 0; d < 4; ++d) win[d] = win[d + 1];
            }
        }
        __syncthreads();
        f32x4 acc = {0.f, 0.f, 0.f, 0.f};
        {
            const ldsp abase = wave < 4 ? XCT + r16 * RS + (512 * wave) * 2 : lds + (2 + r16) * RS + (512 * (wave - 4)) * 2;
            const bf16_t* bbase = GW + (size_t)r16 * 4096 + 512 * wave;
#pragma unroll 4
            for (int ks = 0; ks < 16; ++ks) acc = __builtin_amdgcn_mfma_f32_16x16x32_bf16(*(const LAS bf16x8*)(abase + (ks * 32 + kq * 8) * 2), *(const bf16x8*)(bbase + ks * 32 + kq * 8), acc, 0, 0, 0);
        }
        __syncthreads();
#pragma unroll
        for (int j = 0; j < 4; ++j) red[wave * 256 + (4 * kq + j) * 16 + r16] = acc[j];
        __syncthreads();
        if (tid < 256) { float sg = bg[tid & 15];
#pragma unroll
            for (int w = 0; w < 8; ++w) sg += red[w * 256 + tid];
            GT[(size_t)(r0 + (tid >> 4)) * 16 + (tid & 15)] = sg; }
        __syncthreads();
    }
}

__device__ __forceinline__ float wscan_add(float v, int lane) {
#pragma unroll
    for (int o = 1; o < 64; o <<= 1) { const float t = __shfl_up(v, o); if (lane >= o) v += t; }
    return v;
}
__device__ __forceinline__ float wscan_max(float v, int lane) {
#pragma unroll
    for (int o = 1; o < 64; o <<= 1) { const float t = __shfl_up(v, o); if (lane >= o) v = fmaxf(v, t); }
    return v;
}

__device__ __forceinline__ void mlstm_scores(const Args& a, ldsp lds, int vcu, int G, int tid, int wave, int lane) {
    const bf16_t* XC = (const bf16_t*)(a.ws + WS_BIG + SLOT); const float* GT = (const float*)(a.ws + WS_GATES);
    bf16_t* SG = (bf16_t*)(a.ws + WS_Y) + (size_t)HT * DM;
    float* RG = (float*)(a.ws + WS_DT);
    constexpr int LQ = 72, LT = 136;
    LAS float* IG = (LAS float*)(lds + 0); LAS float* LF = IG + 256; LAS float* AV = IG + 512; LAS float* PM = IG + 768; LAS float* DN = IG + 1024; LAS float* BVS = IG + 1536;
    LAS bf16_t* QS = (LAS bf16_t*)(lds + 9216); LAS bf16_t* KS = (LAS bf16_t*)(lds + 27648); LAS bf16_t* TS = (LAS bf16_t*)(lds + 9216);
    const bf16_t* WQT = (const bf16_t*)(a.ws + WS_WQT); const bf16_t* WKT = (const bf16_t*)(a.ws + WS_WKT);
    typedef short s16x4 __attribute__((ext_vector_type(4)));
    const int xb = lane >> 2, xi = lane & 3;
    const int r16 = lane & 15, kq = lane >> 4;
    for (int u = vcu; u < 4 * 4 * NCH; u += G) {
        const int c = u % NCH, h = (u / NCH) & 3, bl = u / (4 * NCH);
        const size_t rb = (size_t)bl * TB + (size_t)c * CH;
        if (tid < 256) { const int dx = tid >> 7, r = tid & 127; const float* g = GT + (rb + r) * 16 + dx * 8 + h; IG[tid] = g[0]; const float f = g[4]; LF[tid] = fminf(f, 0.f) - log1pf(__expf(-fabsf(f))); }
        __syncthreads();
        if (wave < 2) { const int dir = wave; const int p0 = 2 * lane, p1 = 2 * lane + 1, n0 = dir ? 127 - p0 : p0, n1 = dir ? 127 - p1 : p1;
            const float l0 = LF[dir * 128 + n0], l1 = LF[dir * 128 + n1], i0 = IG[dir * 128 + n0], i1 = IG[dir * 128 + n1];
            const float S = wscan_add(l0 + l1, lane), b1 = S, b0 = S - l1, a0 = i0 - b0, a1 = i1 - b1;
            const float PMX = wscan_max(fmaxf(a0, a1), lane); float pex = __shfl_up(PMX, 1); if (lane == 0) pex = -INFINITY;
            AV[dir * 128 + n0] = a0; AV[dir * 128 + n1] = a1; PM[dir * 128 + n0] = fmaxf(pex, a0); PM[dir * 128 + n1] = fmaxf(pex, fmaxf(a0, a1)); BVS[dir * 128 + n0] = b0; BVS[dir * 128 + n1] = b1; }
        f32x4 Sacc[2][4];
#pragma unroll
        for (int x = 0; x < 2; ++x)
#pragma unroll
            for (int y = 0; y < 4; ++y) Sacc[x][y] = (f32x4){0.f, 0.f, 0.f, 0.f};
        const char* xcb = (const char*)(XC + rb * INNER + h * 512);
        const unsigned xoff = (unsigned)((16 * wave + xi) * INNER + 4 * xb) * 2u, woff = (unsigned)((h * 128 + xb) * 16 + xi * 4) * 2u;
        u32x2 xg[4], wqf, wkf;
#pragma unroll
        for (int g = 0; g < 4; ++g) xg[g] = *(const u32x2*)(xcb + xoff + (unsigned)(4 * g * INNER * 2));
        wqf = *(const u32x2*)((const char*)WQT + woff); wkf = *(const u32x2*)((const char*)WKT + woff);
#pragma unroll
        for (int i = 0; i < 8; ++i) {
            {
                const s16x4 wqa = __builtin_bit_cast(s16x4, wqf), wka = __builtin_bit_cast(s16x4, wkf);
#pragma unroll
                for (int g = 0; g < 4; ++g) { const s16x4 xf = __builtin_bit_cast(s16x4, xg[g]); const f32x4 z4 = {0.f, 0.f, 0.f, 0.f};
                    const f32x4 q = __builtin_amdgcn_mfma_f32_4x4x4bf16_1k(wqa, xf, z4, 0, 0, 0), k = __builtin_amdgcn_mfma_f32_4x4x4bf16_1k(wka, xf, z4, 0, 0, 0);
                    u32x2 qp, kp; qp.x = pk_bf16(q[0], q[1]); qp.y = pk_bf16(q[2], q[3]); kp.x = pk_bf16(k[0], k[1]); kp.y = pk_bf16(k[2], k[3]);
                    *(LAS u32x2*)(QS + (16 * wave + 4 * g + xi) * LQ + 4 * xb) = qp; *(LAS u32x2*)(KS + (16 * wave + 4 * g + xi) * LQ + 4 * xb) = kp; }
            }
            __syncthreads();
            if (i < 7) {
#pragma unroll
                for (int g = 0; g < 4; ++g) xg[g] = *(const u32x2*)(xcb + (unsigned)((i + 1) * 128) + xoff + (unsigned)(4 * g * INNER * 2));
                wqf = *(const u32x2*)((const char*)WQT + woff + (unsigned)((i + 1) * 512)); wkf = *(const u32x2*)((const char*)WKT + woff + (unsigned)((i + 1) * 512));
            }
            wmma<2, 4, 2>(Sacc, QS + (32 * (wave >> 1)) * LQ, LQ, KS + (64 * (wave & 1)) * LQ, LQ, lane);
            __syncthreads();
        }
        const float fbase = (float)(32 * (wave >> 1) + 4 * kq - 64 * (wave & 1) - r16);
#pragma unroll 1
        for (int dir = 0; dir < 2; ++dir) {
            const float sgn = dir ? -1.f : 1.f;
            float cterm[4];
#pragma unroll
            for (int ni = 0; ni < 4; ++ni) cterm[ni] = AV[dir * 128 + 64 * (wave & 1) + 16 * ni + r16];
#pragma unroll
            for (int mi = 0; mi < 2; ++mi)
#pragma unroll
                for (int jj = 0; jj < 4; ++jj) { const int row = 32 * (wave >> 1) + 16 * mi + 4 * kq + jj; const float prow = PM[dir * 128 + row]; float rs = 0.f;
#pragma unroll
                    for (int ni = 0; ni < 4; ++ni) { const int col = 64 * (wave & 1) + 16 * ni + r16;
                        const float pen = fminf(0.f, sgn * (fbase + (float)(16 * mi + jj - 16 * ni))) * 1e30f;
                        const float e = Sacc[mi][ni][jj] * __expf(fminf(cterm[ni] - prow, 0.f) + pen); const bf16_t hb = f2bf(e); TS[row * LT + col] = hb; rs += bf1(hb); }
                    rs += __shfl_xor(rs, 1); rs += __shfl_xor(rs, 2); rs += __shfl_xor(rs, 4); rs += __shfl_xor(rs, 8);
                    if (r16 == 0) DN[(dir * 2 + (wave & 1)) * 128 + row] = rs; }
            __syncthreads();
            const size_t tile = (size_t)u * 2 + dir;
            { bf16_t* dst = SG + tile * (CH * CH);
#pragma unroll
              for (int x = 0; x < 4; ++x) { const int idx = tid + x * NTH, row = idx >> 4, c16 = idx & 15; *(u32x4*)(dst + row * CH + c16 * 8) = *(const LAS u32x4*)(TS + row * LT + c16 * 8); } }
            if (tid < 128) { float* rg = RG + tile * 512; rg[tid] = AV[dir * 128 + tid]; rg[128 + tid] = PM[dir * 128 + tid]; rg[256 + tid] = BVS[dir * 128 + tid];
                rg[384 + tid] = DN[(dir * 2) * 128 + tid] + DN[(dir * 2 + 1) * 128 + tid]; }
            __syncthreads();
        }
    }
}
__device__ __forceinline__ void mlstm_scan(const Args& a, ldsp lds, int vcu, int G, int tid, int wave, int lane) {
    constexpr int SL = 64, NE = SL / 16, NT = SL / 32, NUNIT = 4 * 4 * 2 * (512 / SL);
    typedef short s16x4 __attribute__((ext_vector_type(4)));
    constexpr int LQ = 72, LT = 136, LC = 520;
    LAS float* WGT = (LAS float*)(lds + 0); LAS float* SCV = WGT + 128; LAS float* FTV = WGT + 256; LAS float* MT = WGT + 384; LAS float* DEN = WGT + 512; LAS float* NA = WGT + 640; LAS float* NBF = WGT + 1152; LAS float* NP = WGT + 1664; LAS float* QN = WGT + 2176;
    constexpr int QS0 = 11264, SETB = 35840, KTO = 18432;
    LAS bf16_t* VT = (LAS bf16_t*)(lds + QS0 + SETB);
    LAS bf16_t* CT = (LAS bf16_t*)(lds + QS0 + 2 * SETB);
    LAS bf16_t* NH = CT + SL * 520;
    static_assert(QS0 + 2 * SETB + SL * 1040 + 2048 <= LDS_XB && 128 * 144 == KTO && KTO + 64 * 272 == SETB && SL * 272 <= KTO, "LDS map of the mLSTM state phase");
    const int xb = lane >> 2, xi = lane & 3;
    for (int u = vcu; u < NUNIT; u += G) {
        const int js = u % (512 / SL), dir = (u / (512 / SL)) & 1, h = (u / (1024 / SL)) & 3, bl = u / (4096 / SL);
        f32x4 C[8][1][NT];
#pragma unroll
        for (int i = 0; i < 8; ++i)
#pragma unroll
            for (int tt = 0; tt < NT; ++tt) C[i][0][tt] = (f32x4){0.f, 0.f, 0.f, 0.f};
        for (int i = tid; i < (SL * 1040 + 2048) / 16; i += NTH) ((LAS u32x4*)CT)[i] = (u32x4){0u, 0u, 0u, 0u};
        NA[tid] = 0.f;
        float mprev = 0.f;
        __syncthreads();
        int ncur = 0;
        const int last = dir ? 0 : 127;
#pragma unroll 1
        for (int step = 0; step < NCH; ++step) {
            const int c = chunk_of_step(dir, step);
            const size_t rb = (size_t)bl * TB + (size_t)c * CH;
            const size_t tile = ((size_t)(bl * 4 + h) * NCH + c) * 2 + dir;
            const unsigned char* wsq; { const __attribute__((address_space(4))) Args* kq = (const __attribute__((address_space(4))) Args*)__builtin_amdgcn_kernarg_segment_ptr(); asm volatile("" : "+s"(kq)); wsq = kq->ws; }
            const bf16_t* XC = (const bf16_t*)(wsq + WS_BIG + SLOT); const bf16_t* V = (const bf16_t*)(wsq + WS_BIG + 2 * SLOT);
            bf16_t* HS = (bf16_t*)(wsq + WS_BIG + (dir ? 0 : 3 * SLOT));
            const bf16_t* SG = (const bf16_t*)(wsq + WS_Y) + (size_t)HT * DM; const float* RG = (const float*)(wsq + WS_DT);
            const bf16_t* WQT = (const bf16_t*)(wsq + WS_WQT); const bf16_t* WKT = (const bf16_t*)(wsq + WS_WKT);
            LAS float* Nold = ncur ? NBF : NA; LAS float* Nnew = ncur ? NA : NBF;
            const char* xcb = (const char*)(XC + rb * INNER + h * 512);
            const unsigned xoff = (unsigned)((16 * wave + xi) * INNER + 4 * xb) * 2u;
            const unsigned woff = (unsigned)((h * 128 + xb) * 16 + xi * 4) * 2u;
            u32x2 xg[4], wqf, wkf;
#pragma unroll
            for (int g = 0; g < 4; ++g) xg[g] = *(const u32x2*)(xcb + xoff + (unsigned)(4 * g * INNER * 2));
            wqf = *(const u32x2*)((const char*)WQT + woff); wkf = *(const u32x2*)((const char*)WKT + woff);
            int tp = tid; asm volatile("" : "+v"(tp));
            const float* rg = RG + tile * 512;
            const float bend = rg[256 + last], pmend = rg[128 + last];
            const float mnew = bend + fmaxf(mprev, pmend), dec = __expf(bend + mprev - mnew);
            {
              if (tp < 128) { const float ar = rg[tp], pmr = rg[128 + tp], br = rg[256 + tp];
                  WGT[tp] = __expf(bend + ar - mnew); SCV[tp] = __expf(fminf(0.f, mprev - pmr)); FTV[tp] = __expf(fminf(0.f, pmr - mprev)); MT[tp] = br + fmaxf(mprev, pmr); DEN[tp] = rg[384 + tp]; }
              {
                  const int rowv = tp >> 3, chv = tp & 7; const char* vq = (const char*)(V + rb * INNER + h * 512 + js * SL) + (unsigned)(rowv * INNER * 2 + chv * 16);
#pragma unroll
                  for (int x = 0; x < 2; ++x) { const u32x4 v0 = *(const u32x4*)(vq + (unsigned)(x * 64 * INNER * 2)); *(LAS u32x4*)((ldsp)VT + (64 * x + rowv) * 144 + chv * 16) = v0; } }
            }
#pragma unroll
            for (int i = 0; i < 8; ++i)
#pragma unroll
                for (int tt = 0; tt < NT; ++tt) C[i][0][tt] *= dec;
            f32x4 Iacc[2][2];
#pragma unroll
            for (int x = 0; x < 2; ++x)
#pragma unroll
                for (int y = 0; y < 2; ++y) Iacc[x][y] = (f32x4){0.f, 0.f, 0.f, 0.f};
            float qn[4] = {0.f, 0.f, 0.f, 0.f};
            const LAS bf16_t* NHold = NH + (ncur ? 512 : 0); LAS bf16_t* NHnew = NH + (ncur ? 0 : 512);
            __syncthreads();
            f32x4 wg4[4];
#pragma unroll
            for (int g = 0; g < 4; ++g) wg4[g] = *(const LAS f32x4*)(WGT + 16 * wave + 4 * g);
            bf16x8 vb[NT][4];
            {
                int tv = tid; asm volatile("" : "+v"(tv)); const int l16 = tv & 15, kqv = (tv >> 4) & 3;
                const ldsp vbp = (ldsp)VT + (8 * kqv + (l16 >> 2)) * 144 + ((SL / 2) * (wave & 1) + 4 * (l16 & 3)) * 2;
                typedef short v4i16_t __attribute__((ext_vector_type(4)));
#pragma unroll
                for (int tt = 0; tt < NT; ++tt)
#pragma unroll
                    for (int ks = 0; ks < 4; ++ks) {
                        const v4i16_t lo = __builtin_amdgcn_ds_read_tr16_b64_v4i16((LAS v4i16_t*)(vbp + (32 * ks) * 144 + 32 * tt));
                        const v4i16_t hi = __builtin_amdgcn_ds_read_tr16_b64_v4i16((LAS v4i16_t*)(vbp + (32 * ks + 4) * 144 + 32 * tt));
                        vb[tt][ks] = (bf16x8){lo[0], lo[1], lo[2], lo[3], hi[0], hi[1], hi[2], hi[3]}; } }
#define MK_STAGE(SI) { const int sb_ = (SI) & 1; LAS bf16_t* QSw = (LAS bf16_t*)(lds + QS0 + sb_ * SETB); LAS bf16_t* KTw = (LAS bf16_t*)(lds + QS0 + KTO + sb_ * SETB); LAS float* NPw = sb_ ? (LAS float*)(lds + 9216) : NP; \
                    const s16x4 wqa = __builtin_bit_cast(s16x4, wqf), wkb = __builtin_bit_cast(s16x4, wkf); float nsum = 0.f; \
                    const u32x2 nvp = *(const LAS u32x2*)(NHold + (SI) * 64 + 4 * xb); \
                    _Pragma("unroll") for (int g = 0; g < 4; ++g) { \
                        const s16x4 xf = __builtin_bit_cast(s16x4, xg[g]); const f32x4 z4 = {0.f, 0.f, 0.f, 0.f}; \
                        const f32x4 q = __builtin_amdgcn_mfma_f32_4x4x4bf16_1k(wqa, xf, z4, 0, 0, 0);       \
                        f32x4 k = __builtin_amdgcn_mfma_f32_4x4x4bf16_1k(xf, wkb, z4, 0, 0, 0);             \
                        k *= wg4[g]; nsum += (k[0] + k[1]) + (k[2] + k[3]); \
                        u32x2 qp, kp; qp.x = pk_bf16(q[0], q[1]); qp.y = pk_bf16(q[2], q[3]); kp.x = pk_bf16(k[0], k[1]); kp.y = pk_bf16(k[2], k[3]); \
                        *(LAS u32x2*)(QSw + (16 * wave + 4 * g + xi) * LQ + 4 * xb) = qp; \
                        *(LAS u32x2*)(KTw + (4 * xb + xi) * LT + 16 * wave + 4 * g) = kp; \
                        asm("v_dot2c_f32_bf16 %0, %1, %2" : "+v"(qn[g]) : "v"(qp.x), "v"(nvp.x));     \
                        asm("v_dot2c_f32_bf16 %0, %1, %2" : "+v"(qn[g]) : "v"(qp.y), "v"(nvp.y)); \
                    } \
                    NPw[wave * 64 + lane] = nsum;                                   \
                    if ((SI) == 7) {                                                \
                        _Pragma("unroll") for (int g = 0; g < 4; ++g) { float v = qn[g]; v += __shfl_xor(v, 4); v += __shfl_xor(v, 8); v += __shfl_xor(v, 16); v += __shfl_xor(v, 32); if (xb == 0) QN[16 * wave + 4 * g + xi] = v; } \
                    } }
#define MK_PREFETCH(SI) { _Pragma("unroll") for (int g = 0; g < 4; ++g) xg[g] = *(const u32x2*)(xcb + (unsigned)((SI) * 128) + xoff + (unsigned)(4 * g * INNER * 2)); \
                    wqf = *(const u32x2*)((const char*)WQT + woff + (unsigned)((SI) * 512)); wkf = *(const u32x2*)((const char*)WKT + woff + (unsigned)((SI) * 512)); }
            MK_STAGE(0)
            MK_PREFETCH(1)
            __syncthreads();
            u32x4 sfa[4], sfb[4];
#pragma unroll
            for (int i = 0; i < 8; ++i) {
                if (i < 7) { MK_STAGE(i + 1) if (i < 6) MK_PREFETCH(i + 2) }
                else {
                    int tq = tid; asm volatile("" : "+v"(tq)); const char* src = (const char*)(SG + tile * (CH * CH)) + (unsigned)(((32 * (wave >> 1) + (tq & 15)) * CH + ((tq >> 4) & 3) * 8) * 2);
#pragma unroll
                    for (int ks = 0; ks < 4; ++ks) sfa[ks] = *(const u32x4*)(src + ks * 64); }
                const int cb = i & 1; const LAS bf16_t* QSr = (const LAS bf16_t*)(lds + QS0 + cb * SETB); const LAS bf16_t* KTr = (const LAS bf16_t*)(lds + QS0 + KTO + cb * SETB); const LAS float* NPr = cb ? (const LAS float*)(lds + 9216) : NP;
                wmma<2, 2, 2>(Iacc, CT + ((SL / 2) * (wave & 1)) * LC + i * 64, LC, QSr + (32 * (wave >> 1)) * LQ, LQ, lane);
                {
                    const LAS bf16_t* Ak = KTr + (16 * (wave >> 1) + (lane & 15)) * LT + (lane >> 4) * 8;
                    bf16x8 af[4];
#pragma unroll
                    for (int ks = 0; ks < 4; ++ks) af[ks] = *(const LAS bf16x8*)(Ak + ks * 32);
#define MK_UPD(ci) { _Pragma("unroll") for (int ks = 0; ks < 4; ++ks) _Pragma("unroll") for (int tt = 0; tt < NT; ++tt) C[ci][0][tt] = __builtin_amdgcn_mfma_f32_16x16x32_bf16(af[ks], vb[tt][ks], C[ci][0][tt], 0, 0, 0); }
                    MK_UPD(i)
#undef MK_UPD
                }
                if (tid < 64) {
                    float pv[8]; const float nold = Nold[i * 64 + tid];
#pragma unroll
                    for (int w = 0; w < 8; ++w) pv[w] = NPr[w * 64 + tid];
                    asm volatile("s_waitcnt lgkmcnt(0)" ::: "memory");
                    const float ks = ((pv[0] + pv[1]) + (pv[2] + pv[3])) + ((pv[4] + pv[5]) + (pv[6] + pv[7]));
                    const float nn = dec * nold + ks; Nnew[i * 64 + tid] = nn; NHnew[i * 64 + tid] = f2bf(nn);
                }
                __syncthreads();
                __builtin_amdgcn_sched_barrier(0);
            }
#undef MK_STAGE
#undef MK_PREFETCH
            int te = tid; asm volatile("" : "+v"(te));
            const int r16e = te & 15, kqe = (te >> 4) & 3;
            { const char* src = (const char*)(SG + tile * (CH * CH)) + (unsigned)(((32 * (wave >> 1) + 16 + r16e) * CH + kqe * 8) * 2);
#pragma unroll
              for (int ks = 0; ks < 4; ++ks) sfb[ks] = *(const u32x4*)(src + ks * 64); }
#pragma unroll
            for (int i = 0; i < 8; ++i)
#pragma unroll
                for (int tt = 0; tt < NT; ++tt) { u32x2 w; w.x = pk_bf16(C[i][0][tt][0], C[i][0][tt][1]); w.y = pk_bf16(C[i][0][tt][2], C[i][0][tt][3]);
                    *(LAS u32x2*)(CT + ((SL / 2) * (wave & 1) + 16 * tt + r16e) * LC + 64 * i + 16 * (wave >> 1) + 4 * kqe) = w; }
#pragma unroll
            for (int ni = 0; ni < 2; ++ni) {
                const int t = 32 * (wave >> 1) + 16 * ni + r16e;
                f32x4 Nacc[2] = {(f32x4){0.f, 0.f, 0.f, 0.f}, (f32x4){0.f, 0.f, 0.f, 0.f}};
#pragma unroll
                for (int ks = 0; ks < 4; ++ks) { const bf16x8 bfr = __builtin_bit_cast(bf16x8, ni ? sfb[ks] : sfa[ks]);
#pragma unroll
                    for (int mi = 0; mi < 2; ++mi) Nacc[mi] = __builtin_amdgcn_mfma_f32_16x16x32_bf16(vb[mi][ks], bfr, Nacc[mi], 0, 0, 0); }
                const float scv = SCV[t], ft = FTV[t];
                const float den = ft * DEN[t] + scv * QN[t];
                const float inv = 1.f / fmaxf(fabsf(den), __expf(-MT[t]));
                bf16_t* op = (bf16_t*)((char*)(HS + rb * INNER + h * 512 + js * SL + (SL / 2) * (wave & 1)) + (unsigned)(t * INNER + 4 * kqe) * 2u);
#pragma unroll
                for (int mi = 0; mi < 2; ++mi) { float o[4];
#pragma unroll
                    for (int jj = 0; jj < 4; ++jj) o[jj] = (ft * Nacc[mi][jj] + scv * Iacc[mi][ni][jj]) * inv;
                    u32x2 w; w.x = pk_bf16(o[0], o[1]); w.y = pk_bf16(o[2], o[3]); *(u32x2*)(op + 16 * mi) = w; }
            }
            __syncthreads();
            mprev = mnew; ncur ^= 1;
        }
    }
}
__device__ __forceinline__ void mlstm_readout(const Args& a, int gw, int NGW, int lane) {
    const bf16_t* XC = (const bf16_t*)(a.ws + WS_BIG + SLOT); bf16_t* HSF = (bf16_t*)(a.ws + WS_BIG + 3 * SLOT); const bf16_t* HSB = (const bf16_t*)(a.ws + WS_BIG);
    const float* ng = a.in[18]; const float* sk = a.in[19];
    for (int r = gw; r < HT; r += NGW) {
#pragma unroll
        for (int hh = 0; hh < 4; ++hh) { const size_t o = (size_t)r * INNER + 512 * hh + 8 * lane; const int col = 512 * hh + 8 * lane;
            float v[8], w[8], xc[8]; unpack8(*(const u32x4*)(HSF + o), v); unpack8(*(const u32x4*)(HSB + o), w); unpack8(*(const u32x4*)(XC + o), xc);
            float s = 0.f;
#pragma unroll
            for (int j = 0; j < 8; ++j) { v[j] += w[j]; s += v[j]; }
            const float mu = wave_sum(s) * (1.f / 512.f); float s2 = 0.f;
#pragma unroll
            for (int j = 0; j < 8; ++j) { v[j] -= mu; s2 += v[j] * v[j]; }
            const float rstd = rsqrtf(wave_sum(s2) * (1.f / 512.f) + EPS);
            const f32x4 g0 = *(const f32x4*)(ng + col), g1 = *(const f32x4*)(ng + col + 4), k0 = *(const f32x4*)(sk + col), k1 = *(const f32x4*)(sk + col + 4);
#pragma unroll
            for (int j = 0; j < 4; ++j) { v[j] = v[j] * rstd * g0[j] + k0[j] * xc[j]; v[4 + j] = v[4 + j] * rstd * g1[j] + k1[j] * xc[4 + j]; }
            *(u32x4*)(HSF + o) = pack8(v); }
    }
}

__device__ __forceinline__ void ssd_prep(const Args& a, int blk, int G, int tid) {
    const bf16_t* XP = (const bf16_t*)(a.ws + WS_BIG); bf16_t* XO = (bf16_t*)(a.ws + WS_BIG + 2 * SLOT);
    const float* conv_w = a.in[22]; const float* conv_b = a.in[23];
    const int ch = tid * 8;
    float cw[5][8], cb[8];
#pragma unroll
    for (int d = 0; d < 5; ++d) { const f32x4 w0 = *(const f32x4*)(conv_w + d * 4096 + ch), w1 = *(const f32x4*)(conv_w + d * 4096 + ch + 4);
#pragma unroll
        for (int c = 0; c < 4; ++c) { cw[d][c] = w0[c]; cw[d][4 + c] = w1[c]; } }
    { const f32x4 b0 = *(const f32x4*)(conv_b + ch), b1 = *(const f32x4*)(conv_b + ch + 4);
#pragma unroll
      for (int c = 0; c < 4; ++c) { cb[c] = b0[c]; cb[4 + c] = b1[c]; } }
    for (int u = blk; u < HT / 16; u += G) {
        const int r0 = u * 16, t0 = r0 % TB; int slo, shi; conv_seg(t0, slo, shi);
        float win[5][8];
#pragma unroll
        for (int d = 0; d < 4; ++d) { const int t = t0 - 2 + d; u32x4 w = {0u, 0u, 0u, 0u}; if (t >= slo && t < shi) w = *(const u32x4*)(XP + (size_t)(r0 - 2 + d) * 4096 + ch); unpack8(w, win[d]); }
        u32x4 nxt[16];
#pragma unroll
        for (int tt = 0; tt < 16; ++tt) { const int t = t0 + tt + 2; nxt[tt] = (u32x4){0u, 0u, 0u, 0u}; if (t >= slo && t < shi) nxt[tt] = *(const u32x4*)(XP + (size_t)(r0 + tt + 2) * 4096 + ch); }
#pragma unroll
        for (int hb = 0; hb < 2; ++hb) {
            u32x4 ob[8];
#pragma unroll
            for (int t8 = 0; t8 < 8; ++t8) { const int tt = hb * 8 + t8;
                unpack8(nxt[tt], win[4]);
                float o[8];
#pragma unroll
                for (int c = 0; c < 8; ++c) { float sacc = cb[c];
#pragma unroll
                    for (int d = 0; d < 5; ++d) sacc += cw[d][c] * win[d][c];
                    o[c] = silu_f(sacc); }
                ob[t8] = pack8(o);
#pragma unroll
                for (int d = 0; d < 4; ++d)
#pragma unroll
                    for (int c = 0; c < 8; ++c) win[d][c] = win[d + 1][c];
            }
#pragma unroll
            for (int t8 = 0; t8 < 8; ++t8) *(u32x4*)(XO + (size_t)(r0 + hb * 8 + t8) * 4096 + ch) = ob[t8];
        }
    }
}
__device__ __forceinline__ void ssd_scan(const Args& a, ldsp lds, int vcu, int G, int tid, int wave, int lane) {
    const bf16_t* X = (const bf16_t*)(a.ws + WS_BIG + 2 * SLOT); bf16_t* YF = (bf16_t*)(a.ws + WS_BIG); bf16_t* YB = (bf16_t*)(a.ws + WS_BIG + SLOT);
    const float* DT = (const float*)(a.ws + WS_DT);
    constexpr int LT = 136;
    LAS bf16_t* CM = (LAS bf16_t*)(lds + 4096); LAS bf16_t* BM = (LAS bf16_t*)(lds + 38912); LAS bf16_t* BT = (LAS bf16_t*)(lds + 73728); LAS bf16_t* XT = (LAS bf16_t*)(lds + 108544); LAS bf16_t* HB = (LAS bf16_t*)(lds + 125952);
    LAS float* DTV = (LAS float*)(lds + 0); LAS float* CS = DTV + 128; LAS float* ECS = DTV + 256; LAS float* WG = DTV + 384; LAS float* SCAL = DTV + 512;
    const int r16 = lane & 15, kq = lane >> 4;
    typedef short s16x4 __attribute__((ext_vector_type(4)));
    const int xb = lane >> 2, xi = lane & 3;
    const s16x4 idf = {(short)(xi == 0 ? 0x3F80 : 0), (short)(xi == 1 ? 0x3F80 : 0), (short)(xi == 2 ? 0x3F80 : 0), (short)(xi == 3 ? 0x3F80 : 0)};
    for (int u = vcu; u < 256; u += G) {
        const int hr = u & 3, dir = (u >> 2) & 1, g = (u >> 3) & 7, bl = u >> 6, head = g * 4 + hr;
        bf16_t* Y = dir ? YB : YF;
        const float a_neg = -__expf(a.in[25][dir * 32 + head]), dtb = a.in[24][dir * 32 + head], dsk = dir ? 0.f : a.in[26][head];
        f32x4 Hs[1][4];
#pragma unroll
        for (int x = 0; x < 4; ++x) Hs[0][x] = (f32x4){0.f, 0.f, 0.f, 0.f};
        for (int i = tid; i < 17408 / 16; i += NTH) ((LAS u32x4*)HB)[i] = (u32x4){0u, 0u, 0u, 0u};
        u32x4 cmr[4], bmq[4]; u32x2 xgr[4]; float dtn = 0.f;
#define SSD_LOADS(step_) { const size_t rb_ = (size_t)bl * TB + (size_t)chunk_of_step(dir, step_) * CH; int tq = tid; asm volatile("" : "+v"(tq)); \
            const bf16_t* xr_ = X + (rb_ + 16 * wave + ((tq & 63) >> 4)) * 4096 + 3072 + g * 128 + (tq & 15) * 8;     \
            _Pragma("unroll") for (int x = 0; x < 4; ++x) cmr[x] = *(const u32x4*)(xr_ + (size_t)(4 * x) * 4096); \
            const bf16_t* xq_ = X + (rb_ + 16 * wave + (tq & 3)) * 4096 + 4 * ((tq & 63) >> 2); \
            _Pragma("unroll") for (int gq = 0; gq < 4; ++gq) { bmq[gq] = *(const u32x4*)(xq_ + 4 * ((tq & 63) >> 2) + gq * 4 * 4096 + 2048 + g * 128); \
                xgr[gq] = *(const u32x2*)(xq_ + gq * 4 * 4096 + head * 64); } \
            if (tq < 128) dtn = DT[(rb_ + tq) * 64 + dir * 32 + head]; }
        SSD_LOADS(0)
        __syncthreads();
#pragma unroll 1
        for (int step = 0; step < NCH; ++step) {
            const int c = chunk_of_step(dir, step);
            const size_t rb = (size_t)bl * TB + (size_t)c * CH;
            const bool need_y = c >= 2;
            int tp = tid; asm volatile("" : "+v"(tp));
            const int srow = tp & 127, cq = wave >> 1;
            const f32x4 z4 = {0.f, 0.f, 0.f, 0.f};
            if (tp < 128) { const float dt = softplus_f(dtn + dtb); DTV[tp] = dt; CS[tp] = dt * a_neg; }
            {
#pragma unroll
              for (int x = 0; x < 4; ++x) *(LAS u32x4*)(CM + (16 * wave + 4 * x + ((tp & 63) >> 4)) * LT + (tp & 15) * 8) = cmr[x];
#pragma unroll
              for (int gq = 0; gq < 4; ++gq) { const int t0 = 16 * wave + 4 * gq;
                  *(LAS u32x4*)(BM + (t0 + xi) * LT + 8 * xb) = bmq[gq];
                  { const f32x4 d = __builtin_amdgcn_mfma_f32_4x4x4bf16_1k(__builtin_bit_cast(s16x4, xgr[gq]), idf, z4, 0, 0, 0);
                    u32x2 w; w.x = pk_bf16(d[0], d[1]); w.y = pk_bf16(d[2], d[3]); *(LAS u32x2*)(XT + (4 * xb + xi) * LT + t0) = w; } }
            }
            __syncthreads();
            if (wave == 0) {
                const int p0 = 2 * lane, p1 = 2 * lane + 1, n0 = dir ? 127 - p0 : p0, n1 = dir ? 127 - p1 : p1;
                const float l0 = CS[n0], l1 = CS[n1];
                const float S = wscan_add(l0 + l1, lane), c1 = S, c0 = S - l1, cend = __shfl(S, 63);
                CS[n0] = c0; CS[n1] = c1; ECS[n0] = __expf(c0); ECS[n1] = __expf(c1);
                WG[n0] = __expf(cend - c0) * DTV[n0]; WG[n1] = __expf(cend - c1) * DTV[n1];
                if (lane == 0) SCAL[0] = __expf(cend);
            }
            f32x4 CB[2][4], Iacc[4][1];
#pragma unroll
            for (int x = 0; x < 2; ++x)
#pragma unroll
                for (int y = 0; y < 4; ++y) CB[x][y] = (f32x4){0.f, 0.f, 0.f, 0.f};
#pragma unroll
            for (int x = 0; x < 4; ++x) Iacc[x][0] = (f32x4){0.f, 0.f, 0.f, 0.f};
            if (need_y) wmma<2, 4, 4>(CB, BM + (32 * (wave >> 1)) * LT, LT, CM + (64 * (wave & 1)) * LT, LT, lane);
            if (need_y) wmma<4, 1, 4>(Iacc, HB, LT, CM + (16 * wave) * LT, LT, lane);
            __syncthreads();
            {
#pragma unroll
              for (int gq = 0; gq < 4; ++gq) { const int t0 = 16 * wave + 4 * gq; const f32x4 wg4 = *(const LAS f32x4*)(WG + t0);
#pragma unroll
                  for (int ch = 0; ch < 2; ++ch) {
                      const u32x2 bh = ch ? (u32x2){bmq[gq].z, bmq[gq].w} : (u32x2){bmq[gq].x, bmq[gq].y};
                      f32x4 d = __builtin_amdgcn_mfma_f32_4x4x4bf16_1k(__builtin_bit_cast(s16x4, bh), idf, z4, 0, 0, 0);
                      d *= wg4; u32x2 w; w.x = pk_bf16(d[0], d[1]); w.y = pk_bf16(d[2], d[3]); *(LAS u32x2*)(BT + (8 * xb + 4 * ch + xi) * LT + t0) = w; } }
            }
            LAS bf16_t* MM = CM;
            const float sgn = dir ? -1.f : 1.f, fbase = (float)(64 * (wave & 1) + r16 - 32 * (wave >> 1) - 4 * kq);
            if (need_y) {
            float cst[4];
#pragma unroll
            for (int ni = 0; ni < 4; ++ni) cst[ni] = CS[64 * (wave & 1) + 16 * ni + r16];
#pragma unroll
            for (int mi = 0; mi < 2; ++mi) { const int s0 = 32 * (wave >> 1) + 16 * mi + 4 * kq; const f32x4 css = *(const LAS f32x4*)(CS + s0), dts = *(const LAS f32x4*)(DTV + s0);
#pragma unroll
                for (int ni = 0; ni < 4; ++ni) { const int t = 64 * (wave & 1) + 16 * ni + r16; float e[4];
#pragma unroll
                    for (int jj = 0; jj < 4; ++jj) { const float pen = fminf(0.f, sgn * (fbase + (float)(16 * ni - 16 * mi - jj))) * 1e30f;
                        e[jj] = CB[mi][ni][jj] * __expf(fminf(cst[ni] - css[jj], 0.f) + pen) * dts[jj]; }
                    u32x2 w; w.x = pk_bf16(e[0], e[1]); w.y = pk_bf16(e[2], e[3]); *(LAS u32x2*)(MM + t * LT + s0) = w; } }
            }
            if (step + 1 < NCH) SSD_LOADS(step + 1)
            __syncthreads();
            f32x4 Yacc[4][1];
#pragma unroll
            for (int x = 0; x < 4; ++x) Yacc[x][0] = (f32x4){0.f, 0.f, 0.f, 0.f};
            if (need_y) {
            wmma<4, 1, 4>(Yacc, XT, LT, MM + (16 * wave) * LT, LT, lane);
            { const int t = 16 * wave + r16; const float ecs = ECS[t]; bf16_t* op = Y + (rb + t) * INNER + head * 64 + 4 * kq;
#pragma unroll
              for (int mi = 0; mi < 4; ++mi) { float o[4];
#pragma unroll
                  for (int jj = 0; jj < 4; ++jj) o[jj] = Yacc[mi][0][jj] + ecs * Iacc[mi][0][jj] + dsk * bf1(XT[(16 * mi + 4 * kq + jj) * LT + t]);
                  u32x2 w; w.x = cvt_pk_bf16(o[0], o[1]); w.y = cvt_pk_bf16(o[2], o[3]); *(u32x2*)(op + 16 * mi) = w; } }
            }
            const float dec = SCAL[0];
#pragma unroll
            for (int x = 0; x < 4; ++x) Hs[0][x] *= dec;
            wmma<1, 4, 4>(Hs, BT + (16 * wave) * LT, LT, XT, LT, lane);
#pragma unroll
            for (int ni = 0; ni < 4; ++ni) { u32x2 w; w.x = pk_bf16(Hs[0][ni][0], Hs[0][ni][1]); w.y = pk_bf16(Hs[0][ni][2], Hs[0][ni][3]);
                *(LAS u32x2*)(HB + (16 * ni + r16) * LT + 16 * wave + 4 * kq) = w; }
            __syncthreads();
        }
#undef SSD_LOADS
    }
}

typedef const __attribute__((address_space(4))) Args* KArgsPtr;
__global__ void __launch_bounds__(NTH, 2) fwd(Args a_unused) {
    extern __shared__ __attribute__((aligned(16))) unsigned char lds_raw[];
    const ldsp lds = (ldsp)lds_raw;
    const int G = gridDim.x;
    if (threadIdx.x == 0) *(LAS u32x4*)(lds + LDS_XB) = (u32x4){0u, 0u, 0u, 0u};
    __syncthreads();
    (void)xcd_barrier_post((unsigned*)(a_unused.ws + WS_CTL), (volatile LAS unsigned*)(lds + LDS_XB));
    const int NGW = G * NWAVES;
#define IDS int tid_ = threadIdx.x, blk_ = blockIdx.x; KArgsPtr kp_ = (KArgsPtr)__builtin_amdgcn_kernarg_segment_ptr(); asm volatile("" : "+v"(tid_), "+s"(blk_), "+s"(kp_)); \
    const Args& a = *(const Args*)kp_; unsigned char* const ws = a.ws; \
    const int lane_ = tid_ & 63, wave_ = __builtin_amdgcn_readfirstlane(tid_ >> 6), gw_ = blk_ * NWAVES + wave_, vcu_ = (G % 8 == 0) ? (blk_ % 8) * (G / 8) + blk_ / 8 : blk_; \
    bf16_t* const W = (bf16_t*)(ws + WS_W); bf16_t* const Hb = (bf16_t*)(ws + WS_H); bf16_t* const Yb = (bf16_t*)(ws + WS_Y); bf16_t* const BIG = (bf16_t*)(ws + WS_BIG); \
    float* const ctxs = (float*)(ws + WS_CTXS); const float* const mod = (const float*)(ws + WS_MOD); \
    (void)lane_; (void)wave_; (void)gw_; (void)vcu_; (void)W; (void)Hb; (void)Yb; (void)BIG; (void)ctxs; (void)mod;
#define PH_END do { KArgsPtr kq_ = (KArgsPtr)__builtin_amdgcn_kernarg_segment_ptr(); asm volatile("" : "+s"(kq_)); XcdBarrier b_; b_.bar = (unsigned*)(((const Args*)kq_)->ws + WS_CTL); \
        b_.x = xb_xcc_id(); b_.st = (volatile LAS unsigned*)(lds + LDS_XB); xcd_barrier(b_); } while (0)

    { IDS convert_layer(a, 0, lds, gw_, NGW, wave_, lane_); __syncthreads(); mods_phase(a, lds, blk_, G, tid_); } PH_END;
    { IDS rows_phase(a.in[0], a.in[2], nullptr, nullptr, nullptr, nullptr, nullptr, nullptr, 0, 0.f, Hb, a.in[6], mod, 0, 0, 0, NB, 0, 0, blk_, G, wave_, lane_); } PH_END;

#pragma unroll 1
    for (int layer = 0; layer < 2; ++layer) {
        const bool last = layer == 1;
#pragma unroll 1
        for (int sub = 0; sub < 2; ++sub) {
            const bool lat_only = last && sub == 1;
            { IDS pg8::Gemm g{Hb, W + (sub ? WO_GU2 : WO_GU1), T, 2 * DFF, DM}; EpiSwiglu E{BIG, DFF};
                if (lat_only) { LatentOrder S; S.init(NB * SEQ, 2 * DFF, G, blk_); pg8::gemm_phase<EpiSwiglu, LatentOrder, false>(lds, g, S, E, nullptr); }
                else { pg8::StaticOrder S; S.init(T, 2 * DFF, G, blk_); pg8::gemm_phase<EpiSwiglu, pg8::StaticOrder, false>(lds, g, S, E, nullptr); } } PH_END;
            { IDS pg8::Gemm g{BIG, W + (sub ? WO_D2 : WO_D1), T, DM, DFF}; pg8::EpiBf16<0> E{Yb, DM, nullptr, 0, 0};
                LatentOrder S; S.init(NB * SEQ, DM, G, blk_); pg8::gemm_phase<pg8::EpiBf16<0>, LatentOrder, false>(lds, g, S, E, nullptr); } PH_END;
            constexpr int NCTXWG = 32;
#define DOWN_CTX() { pg8::Gemm g{BIG, W + (sub ? WO_D2 : WO_D1), T, DM, DFF}; pg8::EpiBf16<0> E{Yb, DM, nullptr, 0, 0}; CtxOrder S; S.init(NB, DM / 256, blk_); \
                     pg8::gemm_phase<pg8::EpiBf16<0>, CtxOrder, false>(lds, g, S, E, nullptr); }
            if (sub == 0) {
#define ROWS1(mode_, blk__, G__) rows_phase(layer == 0 ? a.in[0] : a.out, layer == 0 ? a.in[2] : ctxs, a.out, ctxs, Yb, nullptr, gl + 1 * DM, modl, 2, 0.5f, Hb, gl + 2 * DM, modl, 3, mode_, 0, NB, layer != 0, 1, blk__, G__, wave_, lane_)
                { IDS const float* gl = a.in[6] + (size_t)layer * 6 * DM; const float* modl = mod + (size_t)layer * 9 * 9216;
                    if (blk_ < NCTXWG) DOWN_CTX() else ROWS1(1, blk_ - NCTXWG, G - NCTXWG); } PH_END;
                { IDS const float* gl = a.in[6] + (size_t)layer * 6 * DM; const float* modl = mod + (size_t)layer * 9 * 9216; ROWS1(2, blk_, G); } PH_END;
#undef ROWS1
                if (layer == 0) {
#pragma unroll 1
                    for (int half = 0; half < 2; ++half) {
                        { IDS pg8::Gemm g{Hb + (size_t)half * HT * DM, W + WO_IN, HT, INNER, DM}; pg8::StaticOrder S; S.init(HT, INNER, G, blk_); pg8::EpiBf16<0> E{BIG, INNER, nullptr, 0, 0};
                            pg8::gemm_phase<pg8::EpiBf16<0>, pg8::StaticOrder, false>(lds, g, S, E, nullptr); } PH_END;
                        { IDS mlstm_prep(a, lds, blk_, G, tid_, wave_, lane_); } PH_END;
                        { IDS mlstm_scores(a, lds, vcu_, G, tid_, wave_, lane_); } PH_END;
                        { IDS mlstm_scan(a, lds, vcu_, G, tid_, wave_, lane_); } PH_END;
                        { IDS mlstm_readout(a, gw_, NGW, lane_); } PH_END;
                        { IDS pg8::Gemm g{Hb + (size_t)half * HT * DM, W + WO_IN + (size_t)INNER * DM, HT, INNER, DM}; pg8::StaticOrder S; S.init(HT, INNER, G, blk_);
                            EpiMulSilu<false> E{(bf16_t*)(ws + WS_BIG + 3 * SLOT), nullptr, INNER, nullptr}; pg8::gemm_phase<EpiMulSilu<false>, pg8::StaticOrder, false>(lds, g, S, E, nullptr); } PH_END;
                        { IDS pg8::Gemm g{(const bf16_t*)(ws + WS_BIG + 3 * SLOT), W + WO_OUT, HT, DM, INNER}; LatentOrder S; S.init(HT / 17 * 16, DM, G, blk_);
                            pg8::EpiBf16<0> E{Yb + (size_t)half * HT * DM, DM, nullptr, 0, 0}; pg8::gemm_phase<pg8::EpiBf16<0>, LatentOrder, false>(lds, g, S, E, nullptr); } PH_END;
                        { IDS const float* gl = a.in[6] + (size_t)layer * 6 * DM; const float* modl = mod + (size_t)layer * 9 * 9216;
                            if (blk_ < 16) { pg8::Gemm g{(const bf16_t*)(ws + WS_BIG + 3 * SLOT), W + WO_OUT, HT, DM, INNER}; CtxOrder S; S.init(4, DM / 256, blk_);
                                pg8::EpiBf16<0> E{Yb + (size_t)half * HT * DM, DM, nullptr, 0, 0}; pg8::gemm_phase<pg8::EpiBf16<0>, CtxOrder, false>(lds, g, S, E, nullptr); }
                            else rows_phase(a.out, ctxs, a.out, ctxs, Yb, nullptr, gl + 3 * DM, modl, 5, 1.0f, Hb, gl + 4 * DM, modl, 6, 1, 4 * half, 4 * half + 4, 1, 1, blk_ - 16, G - 16, wave_, lane_); } PH_END;
                    }
                } else {
#pragma unroll 1
                    for (int half = 0; half < 2; ++half) {
                        { IDS pg8::Gemm g{Hb + (size_t)half * HT * DM, W + WO_IN + (size_t)INNER * DM, HT, 4352, DM}; pg8::StaticOrder S; S.init(HT, 4352, G, blk_); EpiSsdIn E{BIG, (float*)(ws + WS_DT)};
                            pg8::gemm_phase<EpiSsdIn, pg8::StaticOrder, false>(lds, g, S, E, nullptr); } PH_END;
                        { IDS ssd_prep(a, blk_, G, tid_); } PH_END;
                        { IDS ssd_scan(a, lds, vcu_, G, tid_, wave_, lane_); } PH_END;
                        { IDS pg8::Gemm g{Hb + (size_t)half * HT * DM, W + WO_IN, HT, INNER, DM}; LatentOrder S; S.init(HT / 17 * 16, INNER, G, blk_);
                            EpiMulSilu<true> E{BIG, (const bf16_t*)(ws + WS_BIG + SLOT), INNER, (float*)(ws + WS_SSQ) + (size_t)half * HT * 32}; pg8::gemm_phase<EpiMulSilu<true>, LatentOrder, false>(lds, g, S, E, nullptr); } PH_END;
                        { IDS pg8::Gemm g{BIG, W + WO_OUT, HT, DM, INNER}; LatentOrder S; S.init(HT / 17 * 16, DM, G, blk_);
                            pg8::EpiBf16<0> E{Yb + (size_t)half * HT * DM, DM, nullptr, 0, 0}; pg8::gemm_phase<pg8::EpiBf16<0>, LatentOrder, false>(lds, g, S, E, nullptr); } PH_END;
                    }
                }
                { IDS const float* gl = a.in[6] + (size_t)layer * 6 * DM; const float* modl = mod + (size_t)layer * 9 * 9216;
                    rows_phase(a.out, ctxs, a.out, ctxs, Yb, last ? (const float*)(ws + WS_SSQ) : nullptr, gl + 3 * DM, modl, 5, 1.0f, Hb, gl + 4 * DM, modl, 6, last ? 1 : 2, 0, NB, 1, 1, blk_, G, wave_, lane_); } PH_END;
            } else {
#define ROWS3(mode_, blk__, G__) rows_phase(a.out, ctxs, a.out, ctxs, Yb, nullptr, gl + 5 * DM, modl, 8, 0.5f, last ? nullptr : Hb, gl + 6 * DM, modl + 9 * 9216, 0, mode_, 0, NB, 1, last ? 0 : 1, blk__, G__, wave_, lane_)
                if (last) { IDS const float* gl = a.in[6] + (size_t)layer * 6 * DM; const float* modl = mod + (size_t)layer * 9 * 9216; ROWS3(1, blk_, G); }
                else {
                    { IDS const float* gl = a.in[6] + (size_t)layer * 6 * DM; const float* modl = mod + (size_t)layer * 9 * 9216;
                        if (blk_ < NCTXWG) DOWN_CTX() else ROWS3(1, blk_ - NCTXWG, G - NCTXWG); } PH_END;
                    { IDS const float* gl = a.in[6] + (size_t)layer * 6 * DM; const float* modl = mod + (size_t)layer * 9 * 9216; ROWS3(2, blk_, G);
                        __syncthreads(); convert_layer(a, 1, lds, gw_, NGW, wave_, lane_); } PH_END;
                }
#undef ROWS3
            }
        }
    }
#undef DOWN_CTX
#undef PH_END
#undef IDS
}
}

extern "C" void kernel_launch(void* const* d_in, const int* in_sizes, int n_in, void* d_out, int out_size, void* d_ws, size_t ws_size, hipStream_t stream) {
    static int grid = 0;
    if (grid == 0) {
        if (n_in != 29 || out_size != mk::NB * mk::SEQ * mk::DM || ws_size < mk::WS_END) {
            fprintf(stderr, "kernel_launch: unexpected problem (n_in %d, out %d, ws %zu, need %zu); nothing launched\n", n_in, out_size, ws_size, (size_t)mk::WS_END); grid = -1; return; }
        int dev = 0, cus = 0, per_cu = 0;
        if (hipGetDevice(&dev) != hipSuccess || hipDeviceGetAttribute(&cus, hipDeviceAttributeMultiprocessorCount, dev) != hipSuccess) { grid = -1; return; }
        if (hipFuncSetAttribute((const void*)mk::fwd, hipFuncAttributeMaxDynamicSharedMemorySize, mk::LDS_BYTES) != hipSuccess) { fprintf(stderr, "kernel_launch: hipFuncSetAttribute failed\n"); grid = -1; return; }
        if (hipOccupancyMaxActiveBlocksPerMultiprocessor(&per_cu, (const void*)mk::fwd, mk::NTH, mk::LDS_BYTES) != hipSuccess || per_cu < 1) {
            fprintf(stderr, "kernel_launch: occupancy query reports %d workgroups per CU; nothing launched\n", per_cu); (void)hipGetLastError(); grid = -1; return; }
        grid = cus;
    }
    if (grid < 0) return;
    if (hipMemsetAsync((char*)d_ws + mk::WS_CTL, 0, mk::CTL_ZERO_BYTES, stream) != hipSuccess) return;
    mk::Args a{};
    for (int i = 0; i < 29; ++i) a.in[i] = (const float*)d_in[i];
    a.out = (float*)d_out; a.ws = (unsigned char*)d_ws; a.ph_lo = 0; a.ph_hi = 0;
    hipLaunchKernelGGL(mk::fwd, dim3(grid), dim3(mk::NTH), mk::LDS_BYTES, stream, a);
}
```

```cpp
#include <hip/hip_runtime.h>
#include <cstdio>
#include <cstdint>
#define XB_TMO      128
#define XB_XCNT(j)  (256  + 64 * (j))
#define XB_XSUB(j)  (1280 + 64 * (j))
#define XB_XGEN(j)  (2304 + 64 * (j))
#define XB_TOP      3328
#define XB_TOPGEN   3392
#define XCD_BAR_WORDS 3456
#define XB_SPIN_CAP (1u << 18)
#define LAS __attribute__((address_space(3)))

__device__ __forceinline__ unsigned xb_ld(unsigned* p)              { return __hip_atomic_load(p, __ATOMIC_RELAXED, __HIP_MEMORY_SCOPE_AGENT); }
__device__ __forceinline__ unsigned xb_add(unsigned* p, unsigned v) { return __hip_atomic_fetch_add(p, v, __ATOMIC_RELAXED, __HIP_MEMORY_SCOPE_AGENT); }
__device__ __forceinline__ unsigned xb_xcc_id() { return (unsigned)__builtin_amdgcn_s_getreg((3 << 11) | 20) & 0xFu; }
#define XB_SPIN(cond, bar) do { unsigned _sp = 0; while (cond) { __builtin_amdgcn_s_sleep(1); \
    if ((++_sp & 255u) == 0u) { if (xb_ld(&(bar)[XB_TMO])) break; if (_sp > XB_SPIN_CAP) { atomicAdd(&(bar)[XB_TMO], 1u); break; } } } } while (0)

struct XcdBarrier {
    unsigned* bar; unsigned x;
    volatile LAS unsigned* st;
};

__device__ __forceinline__ XcdBarrier xcd_barrier_post(unsigned* bar, volatile LAS unsigned* st) {
    XcdBarrier b; b.bar = bar; b.x = xb_xcc_id(); b.st = st;
    if (threadIdx.x == 0) (void)xb_add(&bar[XB_XCNT(b.x)], 1u);
    return b;
}
__device__ __forceinline__ void xcd_barrier_complete(unsigned* bar, unsigned x, unsigned& nloc, unsigned& nx) {
    const unsigned G = gridDim.x * gridDim.y * gridDim.z;
    unsigned sum, cnt, mine, sp = 0u;
    for (;;) {
        sum = 0u; cnt = 0u; mine = 0u;
#pragma unroll
        for (unsigned j = 0; j < 16; ++j) { const unsigned c = xb_ld(&bar[XB_XCNT(j)]); sum += c; cnt += (c > 0u) ? 1u : 0u; mine = (j == x) ? c : mine; }
        if (sum == G) break;
        __builtin_amdgcn_s_sleep(1);
        if ((++sp & 255u) == 0u) { if (xb_ld(&bar[XB_TMO])) break; if (sp > XB_SPIN_CAP) { atomicAdd(&bar[XB_TMO], 1u); break; } }
    }
    nloc = mine > 0u ? mine : 1u; nx = cnt > 0u ? cnt : 1u;
}

__device__ __forceinline__ void xcd_barrier(const XcdBarrier& b) {
    asm volatile("s_waitcnt vmcnt(0)" ::: "memory");
    __syncthreads();
    if (threadIdx.x == 0) {
        unsigned* bar = b.bar;
        __builtin_amdgcn_s_waitcnt(0);
        unsigned nloc = b.st[0], nx = b.st[1];
        if (nloc == 0u) { xcd_barrier_complete(bar, b.x, nloc, nx); b.st[0] = nloc; b.st[1] = nx; }
        const unsigned old = xb_add(&bar[XB_XSUB(b.x)], 1u);
        const unsigned gen = old / nloc;
        if (old + 1u == (gen + 1u) * nloc) {
            __builtin_amdgcn_fence(__ATOMIC_RELEASE, "agent");
            asm volatile("s_waitcnt vmcnt(0)" ::: "memory");
            const unsigned og = xb_add(&bar[XB_TOP], 1u);
            const unsigned tg = og / nx;
            if (og + 1u == (tg + 1u) * nx) xb_add(&bar[XB_TOPGEN], 1u);
            else XB_SPIN(xb_ld(&bar[XB_TOPGEN]) == tg, bar);
            __builtin_amdgcn_fence(__ATOMIC_ACQUIRE, "agent");
            xb_add(&bar[XB_XGEN(b.x)], 1u);
            asm volatile("s_waitcnt vmcnt(0)" ::: "memory");
        } else {
            XB_SPIN(xb_ld(&bar[XB_XGEN(b.x)]) == gen, bar);
            __builtin_amdgcn_fence(__ATOMIC_ACQUIRE, "agent");
            asm volatile("s_waitcnt vmcnt(0)" ::: "memory");
        }
    }
    __syncthreads();
}
namespace pg8 {
#define PG8_LAS __attribute__((address_space(3)))
typedef unsigned short bf16_t;
typedef short bf16x8 __attribute__((ext_vector_type(8)));
typedef float f32x4 __attribute__((ext_vector_type(4)));
typedef unsigned u32x4 __attribute__((ext_vector_type(4)));
constexpr int BM = 256, BK = 64, HALF = 128, HTB = HALF * BK * 2  , STAGE_BYTES = 8 * HTB, NXCD = 8, WGM = 8;

__host__ __device__ __forceinline__ int lds_byte(int r, int c) { const int st = (r >> 4) * 2 + (c >> 5), rr = r & 15, cc = c & 31, ob = rr * 64 + cc * 2; return st * 1024 + (ob ^ (((ob >> 9) & 1) << 5)); }
__host__ __device__ __forceinline__ void stage_rc(int b, int& R, int& C) { const int st = b / 1024, sb = b % 1024, swz = sb ^ (((sb >> 9) & 1) << 5); R = (st >> 1) * 16 + swz / 64; C = (st & 1) * 32 + (swz % 64) / 2; }
__host__ __device__ __forceinline__ int perm32(int rho) { const int n = rho >> 4, i = rho & 15; return 8 * (i >> 2) + 4 * n + (i & 3); }

struct Unit { int pm, pn; };
struct Gemm { const bf16_t* A; const bf16_t* Bt; int M, N, K, ld; };

struct StaticOrder {
    int nM, nN, nwg, G, c;
    __host__ __device__ void init(int M, int N, int G_, int c_) { nM = M / BM; nN = N / BM; nwg = nM * nN; G = G_; c = c_; }
    __host__ __device__ bool next(int i, Unit& u) const {
        const long L = (long)i * G + c; if (L >= nwg) return false;
        int wgid = (int)L; { const int q = nwg / NXCD, r = nwg % NXCD, xcd = wgid % NXCD, off = wgid / NXCD; wgid = (xcd < r ? xcd * (q + 1) : r * (q + 1) + (xcd - r) * q) + off; }
        const int nig = WGM * nN, gid = wgid / nig, fm = gid * WGM, gsz = (nM - fm) < WGM ? (nM - fm) : WGM;
        u.pm = fm + ((wgid % nig) % gsz); u.pn = (wgid % nig) / gsz; return true;
    }
    __device__ __forceinline__ void a_ready(const Unit&) const {}
    __device__ __forceinline__ void done(const Unit&) const {}
};
__device__ __forceinline__ unsigned cvt_pk_bf16(float lo, float hi) { unsigned r; asm volatile("v_cvt_pk_bf16_f32 %0, %1, %2" : "=v"(r) : "v"(lo), "v"(hi)); return r; }
typedef float f32x2 __attribute__((ext_vector_type(2)));
__device__ __forceinline__ f32x2 gelu_pk(f32x2 v) {
    const f32x2 av = __builtin_elementwise_abs(v), d = av * 0.2316418882f + 1.0f;
    f32x2 t; t.x = __builtin_amdgcn_rcpf(d.x); t.y = __builtin_amdgcn_rcpf(d.y);
    f32x2 q = t * 0.5307027145f + (-0.7265760135f); q = q * t + 0.7107068705f; q = q * t + (-0.142248368f); q = q * t + 0.127414796f; q = q * t;
    const f32x2 s = (v * v) * (-0.72134752044f);
    f32x2 e; e.x = __builtin_amdgcn_exp2f(s.x); e.y = __builtin_amdgcn_exp2f(s.y);
    const f32x2 m = v * (q * e), r = v - m;
    f32x2 o; o.x = v.x < 0.f ? m.x : r.x; o.y = v.y < 0.f ? m.y : r.y; return o;
}

struct EpiF32 {
    static constexpr bool PERM = false, AFTER_DRAIN = false;
    float* C; int ldc; const float* bias;
    __device__ __forceinline__ void operator()(const f32x4 (&acc)[2][2][4][2], const Unit& u, int wr, int wc, int fr, int fq) const {
        const int row0 = u.pm * BM + wr * 64 + fr, col0 = u.pn * BM + wc * 32 + 4 * fq;
        f32x4 bv[2][2];
#pragma unroll
        for (int bj = 0; bj < 2; ++bj)
#pragma unroll
            for (int n = 0; n < 2; ++n) bv[bj][n] = bias ? *(const f32x4*)(bias + col0 + bj * HALF + n * 16) : (f32x4){0.f, 0.f, 0.f, 0.f};
#pragma unroll
        for (int ai = 0; ai < 2; ++ai)
#pragma unroll
            for (int m = 0; m < 4; ++m) { float* rowp = C + (size_t)(row0 + ai * HALF + m * 16) * ldc + col0;
#pragma unroll
                for (int bj = 0; bj < 2; ++bj)
#pragma unroll
                    for (int n = 0; n < 2; ++n) *(f32x4*)(rowp + bj * HALF + n * 16) = acc[ai][bj][m][n] + bv[bj][n]; }
    }
};
template <int ACT  > struct EpiBf16 {
    static constexpr bool PERM = true, AFTER_DRAIN = false;
    bf16_t* O; int ldc; const float* bias; int split_cols; size_t split_stride;
    __device__ __forceinline__ void operator()(const f32x4 (&acc)[2][2][4][2], const Unit& u, int wr, int wc, int fr, int fq) const {
        const int row0 = u.pm * BM + wr * 64 + fr; int colt = u.pn * BM; bf16_t* base = O;
        if (split_cols) { const int t = colt / split_cols; base += (size_t)t * split_stride; colt -= t * split_cols; }
        const int col0 = colt + wc * 32 + 8 * fq, bcol0 = u.pn * BM + wc * 32 + 8 * fq;
        f32x4 bv[2][2];
#pragma unroll
        for (int bj = 0; bj < 2; ++bj)
#pragma unroll
            for (int n = 0; n < 2; ++n) bv[bj][n] = bias ? *(const f32x4*)(bias + bcol0 + bj * HALF + 4 * n) : (f32x4){0.f, 0.f, 0.f, 0.f};
#pragma unroll
        for (int ai = 0; ai < 2; ++ai)
#pragma unroll
            for (int m = 0; m < 4; ++m) { bf16_t* rowp = base + (size_t)(row0 + ai * HALF + m * 16) * ldc + col0;
#pragma unroll
                for (int bj = 0; bj < 2; ++bj) { f32x4 v0 = acc[ai][bj][m][0] + bv[bj][0], v1 = acc[ai][bj][m][1] + bv[bj][1];
                    if (ACT == 1) { f32x2 a = gelu_pk((f32x2){v0[0], v0[1]}), b = gelu_pk((f32x2){v0[2], v0[3]}), c = gelu_pk((f32x2){v1[0], v1[1]}), d = gelu_pk((f32x2){v1[2], v1[3]});
                        v0 = (f32x4){a.x, a.y, b.x, b.y}; v1 = (f32x4){c.x, c.y, d.x, d.y}; }
                    if (ACT == 2) {
#pragma unroll
                        for (int j = 0; j < 4; ++j) { v0[j] = 0.5f * v0[j] * (1.0f + erff(v0[j] * 0.70710678f)); v1[j] = 0.5f * v1[j] * (1.0f + erff(v1[j] * 0.70710678f)); } }
                    u32x4 w; w.x = cvt_pk_bf16(v0[0], v0[1]); w.y = cvt_pk_bf16(v0[2], v0[3]); w.z = cvt_pk_bf16(v1[0], v1[1]); w.w = cvt_pk_bf16(v1[2], v1[3]);
                    *(u32x4*)(rowp + bj * HALF) = w; } }
    }
};

template <class Epi, class Sched, bool STAMP = false>
__device__ __forceinline__ void gemm_phase(PG8_LAS unsigned char* lds, const Gemm g, const Sched& S, const Epi& E, unsigned long long* stamps) {
    int tid_raw = threadIdx.x; asm volatile("" : "+v"(tid_raw));
    const int tid = tid_raw, wid = __builtin_amdgcn_readfirstlane(tid >> 6), lane = tid & 63, wr = wid >> 2, wc = wid & 3, fr = lane & 15, fq = lane >> 4;
    const int K = g.K, nt = K / BK, LD = g.ld ? g.ld : K;
    int ts_lo = 0, ts_hi = 0, nts = 0; const unsigned long long rt_entry = STAMP ? (unsigned long long)wall_clock64() : 0ull;
#define PG8_STAMP() do { if (STAMP && wid == 0 && nts < 64) { const unsigned long long _c = (unsigned long long)clock64(); \
        ts_lo = (lane == nts) ? (int)(unsigned)_c : ts_lo; ts_hi = (lane == nts) ? (int)(unsigned)(_c >> 32) : ts_hi; ++nts; } } while (0)
    PG8_STAMP();
    unsigned voffA[2], voffB[2];
#pragma unroll
    for (int i = 0; i < 2; ++i) { int R, C; stage_rc(tid * 16 + i * 8192, R, C); const int Rb = Epi::PERM ? ((R & ~31) + perm32(R & 31)) : R;
        voffA[i] = (unsigned)(R * LD + C) * 2u; voffB[i] = (unsigned)(Rb * LD + C) * 2u; }
    const size_t kstep = (size_t)(BK * 2);
    const size_t hstep = (size_t)HALF * LD * 2;
    const size_t tstep = 2 * hstep;
    const unsigned ldsw = (unsigned)wid * 1024u;
    const int aoff = lds_byte(wr * 64 + fr, fq * 8), boff = lds_byte(wc * 32 + fr, fq * 8);
#define PG8_SA(b, h) (((b) * 2 + (h)) * HTB)
#define PG8_SB(b, h) ((4 + (b) * 2 + (h)) * HTB)
#define PG8_STAGE(bufoff, gbase, voff) do { _Pragma("unroll") for (int _i = 0; _i < 2; ++_i) \
        __builtin_amdgcn_global_load_lds((const unsigned*)((const char*)(gbase) + (voff)[_i]), (PG8_LAS unsigned*)(lds + (bufoff) + ldsw + _i * 8192), 16, 0, 0); } while (0)
#define PG8_LDA(dst, b, h) do { _Pragma("unroll") for (int m = 0; m < 4; ++m) _Pragma("unroll") for (int k = 0; k < 2; ++k) dst[m][k] = *(const PG8_LAS bf16x8*)(lds + PG8_SA(b, h) + aoff + m * 2048 + k * 1024); } while (0)
#define PG8_LDB(dst, b, h) do { _Pragma("unroll") for (int n = 0; n < 2; ++n) _Pragma("unroll") for (int k = 0; k < 2; ++k) dst[n][k] = *(const PG8_LAS bf16x8*)(lds + PG8_SB(b, h) + boff + n * 2048 + k * 1024); } while (0)
#define PG8_MMA(ai, bj, At, Bt) do { __builtin_amdgcn_s_setprio(1); _Pragma("unroll") for (int m = 0; m < 4; ++m) _Pragma("unroll") for (int n = 0; n < 2; ++n) _Pragma("unroll") for (int k = 0; k < 2; ++k) \
        acc[ai][bj][m][n] = __builtin_amdgcn_mfma_f32_16x16x32_bf16(Bt[n][k], At[m][k], acc[ai][bj][m][n], 0, 0, 0); __builtin_amdgcn_s_setprio(0); } while (0)
#define PG8_WAIT_V(n) asm volatile("s_waitcnt vmcnt(" #n ")" ::: "memory")
#define PG8_WAIT_L(n) asm volatile("s_waitcnt lgkmcnt(" #n ")" ::: "memory")
#define PG8_BAR __builtin_amdgcn_s_barrier()
#define PG8_SCHED __builtin_amdgcn_sched_barrier(0)
    Unit cur, nxt; int ui = 0;
    if (!S.next(0, cur)) return;
    f32x4 acc[2][2][4][2];
#pragma unroll
    for (int a = 0; a < 2; ++a)
#pragma unroll
        for (int b = 0; b < 2; ++b)
#pragma unroll
            for (int m = 0; m < 4; ++m)
#pragma unroll
                for (int n = 0; n < 2; ++n) acc[a][b][m][n] = (f32x4){0.f, 0.f, 0.f, 0.f};
    bf16x8 At[4][2], B0[2][2], B1[2][2];
    const char* cA = (const char*)g.A + (size_t)cur.pm * tstep; const char* cB = (const char*)g.Bt + (size_t)cur.pn * tstep;
    S.a_ready(cur);
    PG8_STAGE(PG8_SB(0, 0), cB, voffB); PG8_STAGE(PG8_SA(0, 0), cA, voffA); PG8_STAGE(PG8_SB(0, 1), cB + hstep, voffB); PG8_STAGE(PG8_SA(0, 1), cA + hstep, voffA);
    if (wr == 1) PG8_BAR;
    PG8_WAIT_V(4); PG8_BAR;
    PG8_STAGE(PG8_SB(1, 0), cB + kstep, voffB); PG8_STAGE(PG8_SA(1, 0), cA + kstep, voffA); PG8_STAGE(PG8_SB(1, 1), cB + hstep + kstep, voffB);
    PG8_WAIT_V(6); PG8_BAR;
    PG8_STAMP();
    for (;;) {
        const bool has_next = S.next(ui + 1, nxt);
        const char* nA = has_next ? (const char*)g.A + (size_t)nxt.pm * tstep : cA; const char* nB = has_next ? (const char*)g.Bt + (size_t)nxt.pn * tstep : cB;
        for (int t = 0; t < nt; t += 2) {
            const bool last = (t == nt - 2);
            const char* a1 = cA + (size_t)(t + 1) * kstep;
            const char* a2 = last ? nA : cA + (size_t)(t + 2) * kstep; const char* b2 = last ? nB : cB + (size_t)(t + 2) * kstep;
            const char* a3 = a2 + kstep; const char* b3 = b2 + kstep;
            if (last && has_next) S.a_ready(nxt);
            PG8_LDB(B0, 0, 0); PG8_SCHED; PG8_LDA(At, 0, 0); PG8_STAGE(PG8_SA(1, 1), a1 + hstep, voffA);
            PG8_WAIT_L(8); PG8_BAR; PG8_WAIT_L(0); PG8_MMA(0, 0, At, B0); PG8_BAR; PG8_SCHED;
            PG8_LDB(B1, 0, 1); PG8_STAGE(PG8_SB(0, 0), b2, voffB);
            PG8_BAR; PG8_WAIT_L(0); PG8_MMA(0, 1, At, B1); PG8_BAR;
            PG8_LDA(At, 0, 1); PG8_STAGE(PG8_SA(0, 0), a2, voffA);
            PG8_BAR; PG8_WAIT_L(0); PG8_MMA(1, 0, At, B0); PG8_BAR; PG8_SCHED;
            PG8_STAGE(PG8_SB(0, 1), b2 + hstep, voffB);
            PG8_WAIT_V(6); PG8_BAR; PG8_MMA(1, 1, At, B1); PG8_BAR;
            PG8_LDB(B0, 1, 0); PG8_SCHED; PG8_LDA(At, 1, 0); PG8_STAGE(PG8_SA(0, 1), a2 + hstep, voffA);
            PG8_WAIT_L(8); PG8_BAR; PG8_WAIT_L(0); PG8_MMA(0, 0, At, B0); PG8_BAR; PG8_SCHED;
            PG8_LDB(B1, 1, 1); PG8_STAGE(PG8_SB(1, 0), b3, voffB);
            PG8_BAR; PG8_WAIT_L(0); PG8_MMA(0, 1, At, B1); PG8_BAR;
            PG8_LDA(At, 1, 1); PG8_STAGE(PG8_SA(1, 0), a3, voffA);
            PG8_BAR; PG8_WAIT_L(0); PG8_MMA(1, 0, At, B0); PG8_BAR; PG8_SCHED;
            PG8_STAGE(PG8_SB(1, 1), b3 + hstep, voffB);
            PG8_WAIT_V(6); PG8_BAR; PG8_MMA(1, 1, At, B1); PG8_BAR;
        }
        PG8_STAMP();
        if constexpr (!Epi::AFTER_DRAIN) { E(acc, cur, wr, wc, fr, fq); S.done(cur); }
        PG8_STAMP();
        if (!has_next) break;
#pragma unroll
        for (int a = 0; a < 2; ++a)
#pragma unroll
            for (int b = 0; b < 2; ++b)
#pragma unroll
                for (int m = 0; m < 4; ++m)
#pragma unroll
                    for (int n = 0; n < 2; ++n) acc[a][b][m][n] = (f32x4){0.f, 0.f, 0.f, 0.f};
        cur = nxt; cA = nA; cB = nB; ++ui;
    }
    PG8_WAIT_V(0);
    if (wr == 0) PG8_BAR;
    PG8_BAR;
    if constexpr (Epi::AFTER_DRAIN) { E.fused(acc, cur, wr, wc, fr, fq, lds, wid, lane); S.done(cur); }
    PG8_STAMP();
    if (STAMP && wid == 0) { stamps[lane] = lane < nts ? (((unsigned long long)(unsigned)ts_hi << 32) | (unsigned)ts_lo) : 0ull;
        if (lane == 62) stamps[62] = rt_entry; if (lane == 63) stamps[63] = (unsigned long long)wall_clock64(); }
#undef PG8_STAMP
#undef PG8_SA
#undef PG8_SB
#undef PG8_STAGE
#undef PG8_LDA
#undef PG8_LDB
#undef PG8_MMA
#undef PG8_WAIT_V
#undef PG8_WAIT_L
#undef PG8_BAR
#undef PG8_SCHED
}
}
namespace mk {
using pg8::bf16_t; using pg8::bf16x8; using pg8::f32x4; using pg8::u32x4;
typedef unsigned u32x2 __attribute__((ext_vector_type(2)));
typedef LAS unsigned char* ldsp;

constexpr int DM = 1024, NB = 8, SEQ = 4096, CTX = 256, TB = SEQ + CTX, T = NB * TB, HT = T / 2, DFF = 2816, INNER = 2048;
constexpr int CH = 128, NCH = TB / CH;
constexpr int NWAVES = 8, NTH = 512;
constexpr float EPS = 1e-6f;
constexpr size_t MiB = 1u << 20;
constexpr size_t WS_CTL = 0, CTL_ZERO_BYTES = 128 * 1024;
constexpr size_t WS_MOD = 1 * MiB;
constexpr size_t WS_WG = 1 * MiB + 768 * 1024;
constexpr size_t WS_WQT = 1 * MiB + 960 * 1024, WS_WKT = WS_WQT + 16384;
constexpr size_t WS_GATES = 2 * MiB;
constexpr size_t WS_DT = 3 * MiB + 512 * 1024;
constexpr size_t WS_W = 8 * MiB;
constexpr size_t WS_CTXS = 58 * MiB;
constexpr size_t WS_H = 66 * MiB;
constexpr size_t WS_Y = 134 * MiB;
constexpr size_t WS_BIG = 202 * MiB;
constexpr size_t SLOT = 68 * MiB;
constexpr size_t WS_SSQ = 474 * MiB;
constexpr size_t WS_END = 480 * MiB;
constexpr size_t WO_GU1 = 0, WO_D1 = WO_GU1 + (size_t)2 * DFF * DM, WO_IN = WO_D1 + (size_t)DM * DFF, WO_OUT = WO_IN + (size_t)6400 * DM,
                 WO_GU2 = WO_OUT + (size_t)DM * INNER, WO_D2 = WO_GU2 + (size_t)2 * DFF * DM, WO_END = WO_D2 + (size_t)DM * DFF;
static_assert(WS_W + WO_END * 2 <= WS_CTXS && WS_BIG + 4 * SLOT == WS_SSQ && WS_SSQ + (size_t)T * 32 * 4 <= WS_END && (size_t)HT * INNER * 2 == SLOT && (size_t)T * DFF * 2 <= 4 * SLOT, "d_ws map");
static_assert(WS_GATES + (size_t)HT * 16 * 4 <= WS_DT && WS_DT + (size_t)HT * 64 * 4 <= WS_W && WS_MOD + 2 * 9 * 9216 * 4 <= WS_WG && WS_WG + 16 * 6144 * 2 <= WS_WQT && WS_WKT + 16384 <= WS_GATES, "d_ws map small");
constexpr int LDS_BYTES = 155648;
constexpr int LDS_XB = LDS_BYTES - 16;

typedef __bf16 bf16v2 __attribute__((ext_vector_type(2)));
typedef float f32v2 __attribute__((ext_vector_type(2)));
__device__ __forceinline__ unsigned pk_bf16(float lo, float hi) { const bf16v2 v = __builtin_convertvector((f32v2){lo, hi}, bf16v2); return __builtin_bit_cast(unsigned, v); }
__device__ __forceinline__ unsigned cvt_pk_bf16(float lo, float hi) { return pk_bf16(lo, hi); }
__device__ __forceinline__ float bflo(unsigned w) { return __uint_as_float(w << 16); }
__device__ __forceinline__ float bfhi(unsigned w) { return __uint_as_float(w & 0xffff0000u); }
__device__ __forceinline__ float bf1(unsigned short h) { return __uint_as_float(((unsigned)h) << 16); }
__device__ __forceinline__ unsigned short f2bf(float f) { return (unsigned short)(cvt_pk_bf16(f, 0.f) & 0xffffu); }
__device__ __forceinline__ float silu_f(float x) { return x * __builtin_amdgcn_rcpf(1.f + __expf(-x)); }
__device__ __forceinline__ float softplus_f(float x) { return fmaxf(x, 0.f) + log1pf(__expf(-fabsf(x))); }
#define MK_DPPS(x, ctrl, rmask) __builtin_bit_cast(float, __builtin_amdgcn_update_dpp(0, __builtin_bit_cast(int, (x)), (ctrl), (rmask), 0xF, false))
__device__ __forceinline__ float wave_sum(float v) {
    v += MK_DPPS(v, 0x111, 0xF); v += MK_DPPS(v, 0x112, 0xF); v += MK_DPPS(v, 0x114, 0xF); v += MK_DPPS(v, 0x118, 0xF);
    v += MK_DPPS(v, 0x142, 0xA); v += MK_DPPS(v, 0x143, 0xC);
    return __builtin_bit_cast(float, __builtin_amdgcn_readlane(__builtin_bit_cast(int, v), 63));
}
__device__ __forceinline__ void unpack8(const u32x4 w, float (&f)[8]) {
    f[0] = bflo(w.x); f[1] = bfhi(w.x); f[2] = bflo(w.y); f[3] = bfhi(w.y); f[4] = bflo(w.z); f[5] = bfhi(w.z); f[6] = bflo(w.w); f[7] = bfhi(w.w);
}
__device__ __forceinline__ u32x4 pack8(const float (&f)[8]) {
    u32x4 w; w.x = cvt_pk_bf16(f[0], f[1]); w.y = cvt_pk_bf16(f[2], f[3]); w.z = cvt_pk_bf16(f[4], f[5]); w.w = cvt_pk_bf16(f[6], f[7]); return w;
}
template <int MI, int NI, int KS>
__device__ __forceinline__ void wmma(f32x4 (&acc)[MI][NI], const LAS bf16_t* A, int lda, const LAS bf16_t* B, int ldb, int lane) {
    const int r = lane & 15, kq = lane >> 4;
#pragma unroll
    for (int ks = 0; ks < KS; ++ks) {
        bf16x8 a[MI], b[NI];
#pragma unroll
        for (int mi = 0; mi < MI; ++mi) a[mi] = *(const LAS bf16x8*)(A + (mi * 16 + r) * lda + ks * 32 + kq * 8);
#pragma unroll
        for (int ni = 0; ni < NI; ++ni) b[ni] = *(const LAS bf16x8*)(B + (ni * 16 + r) * ldb + ks * 32 + kq * 8);
#pragma unroll
        for (int mi = 0; mi < MI; ++mi)
#pragma unroll
            for (int ni = 0; ni < NI; ++ni) acc[mi][ni] = __builtin_amdgcn_mfma_f32_16x16x32_bf16(a[mi], b[ni], acc[mi][ni], 0, 0, 0);
    }
}

struct Args { const float* in[29]; float* out; unsigned char* ws; int ph_lo, ph_hi; };

struct LatentOrder : pg8::StaticOrder {
    __device__ bool next(int i, pg8::Unit& u) const { if (!pg8::StaticOrder::next(i, u)) return false; u.pm = (u.pm >> 4) * 17 + 1 + (u.pm & 15); return true; }
};
struct CtxOrder {
    int pm, pn; bool has;
    __device__ void init(int npan, int nN, int c) { has = c < npan * nN; pm = (c % npan) * 17; pn = c / npan; }
    __device__ bool next(int i, pg8::Unit& u) const { if (i > 0 || !has) return false; u.pm = pm; u.pn = pn; return true; }
    __device__ __forceinline__ void a_ready(const pg8::Unit&) const {}
    __device__ __forceinline__ void done(const pg8::Unit&) const {}
};
struct EpiSwiglu {
    static constexpr bool PERM = true, AFTER_DRAIN = false;
    bf16_t* O; int ldc;
    __device__ __forceinline__ void operator()(const f32x4 (&acc)[2][2][4][2], const pg8::Unit& u, int wr, int wc, int fr, int fq) const {
        const int row0 = u.pm * 256 + wr * 64 + fr, col0 = u.pn * 128 + wc * 32 + 8 * fq;
#pragma unroll
        for (int ai = 0; ai < 2; ++ai)
#pragma unroll
            for (int m = 0; m < 4; ++m) {
                float v[8];
#pragma unroll
                for (int n = 0; n < 2; ++n)
#pragma unroll
                    for (int j = 0; j < 4; ++j) v[n * 4 + j] = silu_f(acc[ai][0][m][n][j]) * acc[ai][1][m][n][j];
                *(u32x4*)(O + (size_t)(row0 + ai * 128 + m * 16) * ldc + col0) = pack8(v);
            }
    }
};
template <bool TWO> struct EpiMulSilu {
    static constexpr bool PERM = true, AFTER_DRAIN = false;
    bf16_t* R; const bf16_t* R2; int ldc; float* ssq;
    __device__ __forceinline__ void operator()(const f32x4 (&acc)[2][2][4][2], const pg8::Unit& u, int wr, int wc, int fr, int fq) const {
        const int row0 = u.pm * 256 + wr * 64 + fr, col0 = u.pn * 256 + wc * 32 + 8 * fq;
#pragma unroll
        for (int ai = 0; ai < 2; ++ai)
#pragma unroll
            for (int m = 0; m < 4; ++m) {
                float sq = 0.f;
#pragma unroll
                for (int bj = 0; bj < 2; ++bj) {
                    const size_t o = (size_t)(row0 + ai * 128 + m * 16) * ldc + col0 + bj * 128;
                    float r[8]; unpack8(*(const u32x4*)(R + o), r);
                    if (TWO) { float r2[8]; unpack8(*(const u32x4*)(R2 + o), r2);
#pragma unroll
                        for (int j = 0; j < 8; ++j) r[j] += r2[j]; }
#pragma unroll
                    for (int n = 0; n < 2; ++n)
#pragma unroll
                        for (int j = 0; j < 4; ++j) r[n * 4 + j] *= silu_f(acc[ai][bj][m][n][j]);
                    *(u32x4*)(R + o) = pack8(r);
                    if (TWO) {
#pragma unroll
                        for (int j = 0; j < 8; ++j) sq += r[j] * r[j]; }
                }
                if (TWO) { sq += __shfl_xor(sq, 16); sq += __shfl_xor(sq, 32); if (fq == 0) ssq[(size_t)(row0 + ai * 128 + m * 16) * 32 + u.pn * 4 + wc] = sq; }
            }
    }
};
struct EpiSsdIn {
    static constexpr bool PERM = true, AFTER_DRAIN = false;
    bf16_t* X; float* DT;
    __device__ __forceinline__ void operator()(const f32x4 (&acc)[2][2][4][2], const pg8::Unit& u, int wr, int wc, int fr, int fq) const {
        const int row0 = u.pm * 256 + wr * 64 + fr;
        if (u.pn < 16) {
            const int col0 = u.pn * 256 + wc * 32 + 8 * fq;
#pragma unroll
            for (int ai = 0; ai < 2; ++ai)
#pragma unroll
                for (int m = 0; m < 4; ++m)
#pragma unroll
                    for (int bj = 0; bj < 2; ++bj) {
                        u32x4 w; const f32x4 v0 = acc[ai][bj][m][0], v1 = acc[ai][bj][m][1];
                        w.x = cvt_pk_bf16(v0[0], v0[1]); w.y = cvt_pk_bf16(v0[2], v0[3]); w.z = cvt_pk_bf16(v1[0], v1[1]); w.w = cvt_pk_bf16(v1[2], v1[3]);
                        *(u32x4*)(X + (size_t)(row0 + ai * 128 + m * 16) * 4096 + col0 + bj * 128) = w;
                    }
        } else if (wc < 2) {
            const int col0 = wc * 32 + 8 * fq;
#pragma unroll
            for (int ai = 0; ai < 2; ++ai)
#pragma unroll
                for (int m = 0; m < 4; ++m) {
                    float* p = DT + (size_t)(row0 + ai * 128 + m * 16) * 64 + col0;
                    *(f32x4*)p = acc[ai][0][m][0]; *(f32x4*)(p + 4) = acc[ai][0][m][1];
                }
        }
    }
};

__device__ __forceinline__ void tr_item(const float* W, int ldw, int K, bf16_t* WT, int k0, int n0, int drow0, LAS float* scr, int lane, const float* kscale) {
#pragma unroll 8
    for (int i = 0; i < 32; ++i) { const int kk = 2 * i + (lane >> 5); scr[kk * 33 + (lane & 31)] = W[(size_t)(k0 + kk) * ldw + n0 + (lane & 31)] * (kscale ? kscale[k0 + kk] : 1.f); }
    asm volatile("s_waitcnt lgkmcnt(0)" ::: "memory");
    const int c = lane & 7;
#pragma unroll
    for (int j = 0; j < 4; ++j) { const int n = (lane >> 3) + 8 * j; const LAS float* s = scr + (8 * c) * 33 + n;
        u32x4 o; o.x = cvt_pk_bf16(s[0 * 33], s[1 * 33]); o.y = cvt_pk_bf16(s[2 * 33], s[3 * 33]); o.z = cvt_pk_bf16(s[4 * 33], s[5 * 33]); o.w = cvt_pk_bf16(s[6 * 33], s[7 * 33]);
        *(u32x4*)(WT + (size_t)(drow0 + n) * K + k0 + 8 * c) = o; }
    asm volatile("s_waitcnt lgkmcnt(0)" ::: "memory");
}
__device__ __forceinline__ void convert_layer(const Args& a, int layer, ldsp lds, int gw, int NGW, int wave, int lane) {
    LAS float* scr = (LAS float*)(lds + wave * 16384);
    bf16_t* W = (bf16_t*)(a.ws + WS_W);
    const float* wg0 = a.in[7] + (size_t)(layer * 2 + 0) * DM * DFF; const float* wu0 = a.in[8] + (size_t)(layer * 2 + 0) * DM * DFF; const float* wd0 = a.in[9] + (size_t)(layer * 2 + 0) * DFF * DM;
    const float* wg1 = a.in[7] + (size_t)(layer * 2 + 1) * DM * DFF; const float* wu1 = a.in[8] + (size_t)(layer * 2 + 1) * DM * DFF; const float* wd1 = a.in[9] + (size_t)(layer * 2 + 1) * DFF * DM;
    const float* win = layer == 0 ? a.in[10] : a.in[21]; const int nin = layer == 0 ? 4096 : 6208;
    const float* wout = layer == 0 ? a.in[20] : a.in[28];
    const int total = 4 * 16 * 88 + 2 * 44 * 32 + 16 * (nin / 32) + 32 * 32;
#define MK_TRJOB(src, ldw, K, N, dst, mode, ksc) { const int nb_ = (N) / 32, ni_ = ((K) / 64) * nb_; if (r >= 0 && r < ni_) { const int kb_ = r / nb_, n0_ = (r % nb_) * 32; \
        const int d0_ = (mode) == 0 ? n0_ : 256 * (n0_ / 128) + (n0_ % 128) + ((mode) == 2 ? 128 : 0); tr_item(src, ldw, K, dst, kb_ * 64, n0_, d0_, scr, lane, ksc); } r -= ni_; }
    for (int it = gw; it < total; it += NGW) {
        int r = it;
        MK_TRJOB(wg0, DFF, DM, DFF, W + WO_GU1, 1, nullptr)
        MK_TRJOB(wu0, DFF, DM, DFF, W + WO_GU1, 2, nullptr)
        MK_TRJOB(wg1, DFF, DM, DFF, W + WO_GU2, 1, nullptr)
        MK_TRJOB(wu1, DFF, DM, DFF, W + WO_GU2, 2, nullptr)
        MK_TRJOB(wd0, DM, DFF, DM, W + WO_D1, 0, nullptr)
        MK_TRJOB(wd1, DM, DFF, DM, W + WO_D2, 0, nullptr)
        MK_TRJOB(win, nin, DM, nin, W + WO_IN, 0, nullptr)
        MK_TRJOB(wout, DM, INNER, DM, W + WO_OUT, 0, (layer == 1 ? a.in[27] : nullptr))
    }
#undef MK_TRJOB
    if (layer == 1) {
        u32x4* z = (u32x4*)(W + WO_IN + (size_t)6208 * DM);
        for (int i = gw * 64 + lane; i < 192 * DM / 8; i += NGW * 64) z[i] = (u32x4){0u, 0u, 0u, 0u};
    }
}
__device__ __forceinline__ void mods_phase(const Args& a, ldsp lds, int blk, int G, int tid) {
    LAS float* sv = (LAS float*)lds;
    LAS float* red = (LAS float*)(lds + 40960);
    float* mod = (float*)(a.ws + WS_MOD);
    for (int i = tid; i < 9 * DM; i += NTH) { const int v = i >> 10, k = i & 1023; sv[i] = silu_f(v < 8 ? a.in[1][v * DM + k] : a.in[3][k]); }
    __syncthreads();
    const int col = tid & 63, ks = tid >> 6;
    for (int u = blk; u < 2 * 144; u += G) {
        const int layer = u / 144, n0 = (u % 144) * 64;
        const float* W = a.in[4] + (size_t)layer * DM * 9216 + n0 + col;
        float acc[9];
#pragma unroll
        for (int v = 0; v < 9; ++v) acc[v] = 0.f;
#pragma unroll 8
        for (int k = ks * 128; k < ks * 128 + 128; ++k) { const float w = W[(size_t)k * 9216];
#pragma unroll
            for (int v = 0; v < 9; ++v) acc[v] += sv[v * DM + k] * w; }
#pragma unroll
        for (int v = 0; v < 9; ++v) red[(ks * 9 + v) * 64 + col] = acc[v];
        __syncthreads();
        for (int o = tid; o < 9 * 64; o += NTH) { const int v = o >> 6, cc = o & 63; float s = a.in[5][layer * 9216 + n0 + cc];
#pragma unroll
            for (int q = 0; q < 8; ++q) s += red[(q * 9 + v) * 64 + cc];
            mod[(size_t)(layer * 9 + v) * 9216 + n0 + cc] = s; }
        __syncthreads();
    }
    { bf16_t* wqt = (bf16_t*)(a.ws + WS_WQT); bf16_t* wkt = (bf16_t*)(a.ws + WS_WKT);
      for (int i = blk * NTH + tid; i < 8192; i += G * NTH) { const int bk = i >> 4, j = (i >> 2) & 3, k = i & 3;
          wqt[i] = f2bf(a.in[13][bk * 16 + k * 4 + j]); wkt[i] = f2bf(a.in[14][bk * 16 + k * 4 + j] * 0.04419417382415922f); } }
    {
        bf16_t* gt = (bf16_t*)(a.ws + WS_WG); const float* wq = a.in[13]; const float* wk = a.in[14]; const float* wv = a.in[15]; const float* wg = a.in[16];
        for (int i = blk * NTH + tid; i < 16 * INNER; i += G * NTH) { const int g = i >> 11, ch = i & 2047, bk = ch >> 2, c = ch & 3;
            float sqk = 0.f, sv = 0.f;
#pragma unroll
            for (int d = 0; d < 4; ++d) { sqk += wq[bk * 16 + c * 4 + d] * wg[(size_t)(4 * bk + d) * 16 + g] + wk[bk * 16 + c * 4 + d] * wg[(size_t)(INNER + 4 * bk + d) * 16 + g];
                sv += wv[bk * 16 + c * 4 + d] * wg[(size_t)(2 * INNER + 4 * bk + d) * 16 + g]; }
            gt[g * 4096 + ch] = f2bf(sqk); gt[g * 4096 + INNER + ch] = f2bf(sv); }
    }
}

__device__ __forceinline__ void rows_phase(const float* xs_lat, const float* xs_ctx, float* xd_lat, float* xd_ctx, const bf16_t* yp, const float* ypart, const float* gpost, const float* modg, int jgate, float coef,
                                           bf16_t* hp, const float* gnext, const float* modn, int jshift, int mode, int b0, int b1, int src_bf, int dst_bf, int blk, int G, int wave, int lane) {
    const bool has_y = yp != nullptr, has_h = hp != nullptr, has_xd = xd_lat != nullptr;
    const int per = mode == 1 ? SEQ : mode == 2 ? CTX : TB, toff = mode == 1 ? CTX : 0, nitems = (b1 - b0) * per;
    const int NW = G * NWAVES, RPW = (nitems + NW - 1) / NW; int i_lo = (blk * NWAVES + wave) * RPW; if (i_lo > nitems) i_lo = nitems; const int i_hi = (i_lo + RPW < nitems) ? i_lo + RPW : nitems;
    int b = b0 + i_lo / per, t = toff + i_lo % per;
    int key = -1;
    f32x4 gate[4], gp[4], gn[4], sh[4], sc[4];
#pragma unroll
    for (int j = 0; j < 4; ++j) { gate[j] = gp[j] = gn[j] = sh[j] = sc[j] = (f32x4){0.f, 0.f, 0.f, 0.f}; }
#pragma unroll 2
    for (int it = i_lo; it < i_hi; ++it) {
        const int R = b * TB + t; const bool isctx = t < CTX;
        const int v = isctx ? 8 : b;
        if (v != key) { key = v;
#pragma unroll
            for (int j = 0; j < 4; ++j) { const int col = 256 * j + 4 * lane;
                if (has_y) { gate[j] = *(const f32x4*)(modg + (size_t)(v * 9 + jgate) * DM + col); gp[j] = *(const f32x4*)(gpost + col); }
                if (has_h) { gn[j] = *(const f32x4*)(gnext + col); sh[j] = *(const f32x4*)(modn + (size_t)(v * 9 + jshift) * DM + col); sc[j] = *(const f32x4*)(modn + (size_t)(v * 9 + jshift + 1) * DM + col); } } }
        const size_t xo = isctx ? ((size_t)b * CTX + t) * DM : ((size_t)b * SEQ + (t - CTX)) * DM;
        const float* xs = (isctx ? xs_ctx : xs_lat) + xo;
        f32x4 x[4];
        if (src_bf) {
#pragma unroll
            for (int j = 0; j < 4; ++j) { const u32x2 w = *(const u32x2*)((const bf16_t*)xs + 256 * j + 4 * lane); x[j] = (f32x4){bflo(w.x), bfhi(w.x), bflo(w.y), bfhi(w.y)}; }
        } else {
#pragma unroll
            for (int j = 0; j < 4; ++j) x[j] = *(const f32x4*)(xs + 256 * j + 4 * lane);
        }
        if (has_y) {
            f32x4 yv[4]; float ss = 0.f;
            float ysc = 1.f;
            if (ypart != nullptr) ysc = rsqrtf(wave_sum(lane < 32 ? ypart[(size_t)R * 32 + lane] : 0.f) * (1.f / INNER) + EPS);
#pragma unroll
            for (int j = 0; j < 4; ++j) { const u32x2 w = *(const u32x2*)(yp + (size_t)R * DM + 256 * j + 4 * lane); yv[j] = (f32x4){bflo(w.x), bfhi(w.x), bflo(w.y), bfhi(w.y)} * ysc;
                ss += (yv[j][0] * yv[j][0] + yv[j][1] * yv[j][1]) + (yv[j][2] * yv[j][2] + yv[j][3] * yv[j][3]); }
            const float rstd = rsqrtf(wave_sum(ss) * (1.f / DM) + EPS);
#pragma unroll
            for (int j = 0; j < 4; ++j) x[j] += coef * gate[j] * (yv[j] * rstd * gp[j]);
        }
        if (has_xd) { float* xd = (isctx ? xd_ctx : xd_lat) + xo;
            if (dst_bf) {
#pragma unroll
                for (int j = 0; j < 4; ++j) { u32x2 w; w.x = cvt_pk_bf16(x[j][0], x[j][1]); w.y = cvt_pk_bf16(x[j][2], x[j][3]); *(u32x2*)((bf16_t*)xd + 256 * j + 4 * lane) = w; }
            } else {
#pragma unroll
                for (int j = 0; j < 4; ++j) *(f32x4*)(xd + 256 * j + 4 * lane) = x[j];
            } }
        if (has_h) {
            float ss = 0.f;
#pragma unroll
            for (int j = 0; j < 4; ++j) ss += (x[j][0] * x[j][0] + x[j][1] * x[j][1]) + (x[j][2] * x[j][2] + x[j][3] * x[j][3]);
            const float rstd = rsqrtf(wave_sum(ss) * (1.f / DM) + EPS);
#pragma unroll
            for (int j = 0; j < 4; ++j) { const f32x4 hv = (x[j] * rstd * gn[j]) * (sc[j] + 1.f) + sh[j];
                u32x2 w; w.x = cvt_pk_bf16(hv[0], hv[1]); w.y = cvt_pk_bf16(hv[2], hv[3]); *(u32x2*)(hp + (size_t)R * DM + 256 * j + 4 * lane) = w; }
        }
        if (++t == toff + per) { t = toff; ++b; }
    }
}
__device__ __forceinline__ void conv_seg(int t, int& lo, int& hi) { if (t < CTX) { lo = 0; hi = CTX; } else { lo = CTX + ((t - CTX) >> 6) * 64; hi = lo + 64; } }
__device__ __forceinline__ int chunk_of_step(int dir, int step) { return dir == 0 ? step : (step < 2 ? 1 - step : NCH + 1 - step); }

__device__ __forceinline__ void mlstm_prep(const Args& a, ldsp lds, int blk, int G, int tid, int wave, int lane) {
    const bf16_t* XM = (const bf16_t*)(a.ws + WS_BIG); bf16_t* XC = (bf16_t*)(a.ws + WS_BIG + SLOT); bf16_t* V = (bf16_t*)(a.ws + WS_BIG + 2 * SLOT);
    float* GT = (float*)(a.ws + WS_GATES); const bf16_t* GW = (const bf16_t*)(a.ws + WS_WG);
    const float* conv_w = a.in[11]; const float* conv_b = a.in[12]; const float* wv = a.in[15]; const float* bg = a.in[17];
    constexpr int RS = 4112;
    const ldsp XCT = lds + 82432;
    LAS float* red = (LAS float*)lds;
    static_assert(82432 + 16 * 4112 <= LDS_XB, "LDS map of the mLSTM prep phase");
    const int r16 = lane & 15, kq = lane >> 4, ch = 4 * tid;
    f32x4 cw[5], wvb[4]; const f32x4 cbv = *(const f32x4*)(conv_b + ch);
#pragma unroll
    for (int d = 0; d < 5; ++d) cw[d] = *(const f32x4*)(conv_w + d * INNER + ch);
#pragma unroll
    for (int c = 0; c < 4; ++c) wvb[c] = *(const f32x4*)(wv + tid * 16 + 4 * c);
    bf16x8 gwf[16];
    { const bf16_t* bb = GW + (size_t)r16 * 4096 + 512 * wave + kq * 8;
#pragma unroll
      for (int ks = 0; ks < 16; ++ks) gwf[ks] = *(const bf16x8*)(bb + ks * 32); }
    for (int u = blk; u < HT / 16; u += G) {
        const int r0 = u * 16, t0 = r0 % TB; int slo, shi; conv_seg(t0, slo, shi);
        for (int i = tid; i < 20 * 256; i += NTH) { const int rr = i >> 8, c16 = i & 255, t = t0 - 2 + rr;
            u32x4 val = {0u, 0u, 0u, 0u}; if (t >= slo && t < shi) val = *(const u32x4*)(XM + (size_t)(r0 - 2 + rr) * INNER + c16 * 8);
            *(LAS u32x4*)(lds + rr * RS + c16 * 16) = val; }
        __syncthreads();
        {
            f32x4 win[5];
#pragma unroll
            for (int d = 0; d < 4; ++d) { const u32x2 w = *(const LAS u32x2*)(lds + d * RS + ch * 2); win[d] = (f32x4){bflo(w.x), bfhi(w.x), bflo(w.y), bfhi(w.y)}; }
#pragma unroll
            for (int tt = 0; tt < 16; ++tt) {
                { const u32x2 w = *(const LAS u32x2*)(lds + (tt + 4) * RS + ch * 2); win[4] = (f32x4){bflo(w.x), bfhi(w.x), bflo(w.y), bfhi(w.y)}; }
                f32x4 sacc = cbv;
#pragma unroll
                for (int d = 0; d < 5; ++d) sacc += cw[d] * win[d];
                const f32x4 xc = {silu_f(sacc[0]), silu_f(sacc[1]), silu_f(sacc[2]), silu_f(sacc[3])};
                const f32x4 vv = win[2][0] * wvb[0] + win[2][1] * wvb[1] + win[2][2] * wvb[2] + win[2][3] * wvb[3];
                u32x2 xw, vw; xw.x = pk_bf16(xc[0], xc[1]); xw.y = pk_bf16(xc[2], xc[3]); vw.x = pk_bf16(vv[0], vv[1]); vw.y = pk_bf16(vv[2], vv[3]);
                *(u32x2*)(XC + (size_t)(r0 + tt) * INNER + ch) = xw; *(u32x2*)(V + (size_t)(r0 + tt) * INNER + ch) = vw;
                *(LAS u32x2*)(XCT + tt * RS + ch * 2) = xw;
#pragma unroll
                for (int d = 0; d < 4; ++d) win[d] = win[d + 1];
            }
        }
        __syncthreads();
        f32x4 acc = {0.f, 0.f, 0.f, 0.f};
        {
            const ldsp abase = wave < 4 ? XCT + r16 * RS + (512 * wave) * 2 : lds + (2 + r16) * RS + (512 * (wave - 4)) * 2;
#pragma unroll
            for (int ks = 0; ks < 16; ++ks) acc = __builtin_amdgcn_mfma_f32_16x16x32_bf16(*(const LAS bf16x8*)(abase + (ks * 32 + kq * 8) * 2), gwf[ks], acc, 0, 0, 0);
        }
        __syncthreads();
#pragma unroll
        for (int j = 0; j < 4; ++j) red[wave * 256 + (4 * kq + j) * 16 + r16] = acc[j];
        __syncthreads();
        if (tid < 256) { float sg = bg[tid & 15];
#pragma unroll
            for (int w = 0; w < 8; ++w) sg += red[w * 256 + tid];
            GT[(size_t)(r0 + (tid >> 4)) * 16 + (tid & 15)] = sg; }
        __syncthreads();
    }
}

#define MK_DPP(x, idbits, ctrl, rmask) __builtin_bit_cast(float, __builtin_amdgcn_update_dpp((int)(idbits), __builtin_bit_cast(int, (x)), (ctrl), (rmask), 0xF, false))
__device__ __forceinline__ float wscan_add(float v, int lane) {
    (void)lane;
    v += MK_DPP(v, 0, 0x111, 0xF); v += MK_DPP(v, 0, 0x112, 0xF); v += MK_DPP(v, 0, 0x114, 0xF); v += MK_DPP(v, 0, 0x118, 0xF);
    v += MK_DPP(v, 0, 0x142, 0xA); v += MK_DPP(v, 0, 0x143, 0xC);
    return v;
}
__device__ __forceinline__ float wscan_max(float v, int lane) {
    (void)lane;
    v = fmaxf(v, MK_DPP(v, 0xFF800000u, 0x111, 0xF)); v = fmaxf(v, MK_DPP(v, 0xFF800000u, 0x112, 0xF)); v = fmaxf(v, MK_DPP(v, 0xFF800000u, 0x114, 0xF)); v = fmaxf(v, MK_DPP(v, 0xFF800000u, 0x118, 0xF));
    v = fmaxf(v, MK_DPP(v, 0xFF800000u, 0x142, 0xA)); v = fmaxf(v, MK_DPP(v, 0xFF800000u, 0x143, 0xC));
    return v;
}

__device__ __forceinline__ void mlstm_scores(const Args& a, ldsp lds, int vcu, int G, int tid, int wave, int lane) {
    const bf16_t* XC = (const bf16_t*)(a.ws + WS_BIG + SLOT); const float* GT = (const float*)(a.ws + WS_GATES);
    bf16_t* SG = (bf16_t*)(a.ws + WS_Y) + (size_t)HT * DM;
    float* RG = (float*)(a.ws + WS_DT);
    constexpr int LQ = 72, LT = 136;
    LAS float* IG = (LAS float*)(lds + 0); LAS float* LF = IG + 256; LAS float* AV = IG + 512; LAS float* PM = IG + 768; LAS float* DN = IG + 1024; LAS float* BVS = IG + 1536;
    LAS bf16_t* QS = (LAS bf16_t*)(lds + 9216); LAS bf16_t* KS = (LAS bf16_t*)(lds + 27648); LAS bf16_t* TS = (LAS bf16_t*)(lds + 9216);
    const bf16_t* WQT = (const bf16_t*)(a.ws + WS_WQT); const bf16_t* WKT = (const bf16_t*)(a.ws + WS_WKT);
    typedef short s16x4 __attribute__((ext_vector_type(4)));
    const int xb = lane >> 2, xi = lane & 3;
    const int r16 = lane & 15, kq = lane >> 4;
    for (int u = vcu; u < 4 * 4 * NCH; u += G) {
        const int c = u % NCH, h = (u / NCH) & 3, bl = u / (4 * NCH);
        const size_t rb = (size_t)bl * TB + (size_t)c * CH;
        if (tid < 256) { const int dx = tid >> 7, r = tid & 127; const float* g = GT + (rb + r) * 16 + dx * 8 + h; IG[tid] = g[0]; const float f = g[4]; LF[tid] = fminf(f, 0.f) - log1pf(__expf(-fabsf(f))); }
        __syncthreads();
        if (wave < 2) { const int dir = wave; const int p0 = 2 * lane, p1 = 2 * lane + 1, n0 = dir ? 127 - p0 : p0, n1 = dir ? 127 - p1 : p1;
            const float l0 = LF[dir * 128 + n0], l1 = LF[dir * 128 + n1], i0 = IG[dir * 128 + n0], i1 = IG[dir * 128 + n1];
            const float S = wscan_add(l0 + l1, lane), b1 = S, b0 = S - l1, a0 = i0 - b0, a1 = i1 - b1;
            const float PMX = wscan_max(fmaxf(a0, a1), lane); float pex = __shfl_up(PMX, 1); if (lane == 0) pex = -INFINITY;
            AV[dir * 128 + n0] = a0; AV[dir * 128 + n1] = a1; PM[dir * 128 + n0] = fmaxf(pex, a0); PM[dir * 128 + n1] = fmaxf(pex, fmaxf(a0, a1)); BVS[dir * 128 + n0] = b0; BVS[dir * 128 + n1] = b1; }
        f32x4 Sacc[2][4];
#pragma unroll
        for (int x = 0; x < 2; ++x)
#pragma unroll
            for (int y = 0; y < 4; ++y) Sacc[x][y] = (f32x4){0.f, 0.f, 0.f, 0.f};
        const char* xcb = (const char*)(XC + rb * INNER + h * 512);
        const unsigned xoff = (unsigned)((16 * wave + xi) * INNER + 4 * xb) * 2u, woff = (unsigned)((h * 128 + xb) * 16 + xi * 4) * 2u;
        u32x2 xg[4], wqf, wkf;
#pragma unroll
        for (int g = 0; g < 4; ++g) xg[g] = *(const u32x2*)(xcb + xoff + (unsigned)(4 * g * INNER * 2));
        wqf = *(const u32x2*)((const char*)WQT + woff); wkf = *(const u32x2*)((const char*)WKT + woff);
#pragma unroll
        for (int i = 0; i < 8; ++i) {
            {
                const s16x4 wqa = __builtin_bit_cast(s16x4, wqf), wka = __builtin_bit_cast(s16x4, wkf);
#pragma unroll
                for (int g = 0; g < 4; ++g) { const s16x4 xf = __builtin_bit_cast(s16x4, xg[g]); const f32x4 z4 = {0.f, 0.f, 0.f, 0.f};
                    const f32x4 q = __builtin_amdgcn_mfma_f32_4x4x4bf16_1k(wqa, xf, z4, 0, 0, 0), k = __builtin_amdgcn_mfma_f32_4x4x4bf16_1k(wka, xf, z4, 0, 0, 0);
                    u32x2 qp, kp; qp.x = pk_bf16(q[0], q[1]); qp.y = pk_bf16(q[2], q[3]); kp.x = pk_bf16(k[0], k[1]); kp.y = pk_bf16(k[2], k[3]);
                    *(LAS u32x2*)(QS + (16 * wave + 4 * g + xi) * LQ + 4 * xb) = qp; *(LAS u32x2*)(KS + (16 * wave + 4 * g + xi) * LQ + 4 * xb) = kp; }
            }
            __syncthreads();
            if (i < 7) {
#pragma unroll
                for (int g = 0; g < 4; ++g) xg[g] = *(const u32x2*)(xcb + (unsigned)((i + 1) * 128) + xoff + (unsigned)(4 * g * INNER * 2));
                wqf = *(const u32x2*)((const char*)WQT + woff + (unsigned)((i + 1) * 512)); wkf = *(const u32x2*)((const char*)WKT + woff + (unsigned)((i + 1) * 512));
            }
            wmma<2, 4, 2>(Sacc, QS + (32 * (wave >> 1)) * LQ, LQ, KS + (64 * (wave & 1)) * LQ, LQ, lane);
            __syncthreads();
        }
        const float fbase = (float)(32 * (wave >> 1) + 4 * kq - 64 * (wave & 1) - r16);
#pragma unroll 1
        for (int dir = 0; dir < 2; ++dir) {
            const float sgn = dir ? -1.f : 1.f;
            float cterm[4];
#pragma unroll
            for (int ni = 0; ni < 4; ++ni) cterm[ni] = AV[dir * 128 + 64 * (wave & 1) + 16 * ni + r16];
#pragma unroll
            for (int mi = 0; mi < 2; ++mi)
#pragma unroll
                for (int jj = 0; jj < 4; ++jj) { const int row = 32 * (wave >> 1) + 16 * mi + 4 * kq + jj; const float prow = PM[dir * 128 + row]; float rs = 0.f;
#pragma unroll
                    for (int ni = 0; ni < 4; ++ni) { const int col = 64 * (wave & 1) + 16 * ni + r16;
                        const float pen = fminf(0.f, sgn * (fbase + (float)(16 * mi + jj - 16 * ni))) * 1e30f;
                        const float e = Sacc[mi][ni][jj] * __expf(fminf(cterm[ni] - prow, 0.f) + pen); const bf16_t hb = f2bf(e); TS[row * LT + col] = hb; rs += bf1(hb); }
                    rs += __shfl_xor(rs, 1); rs += __shfl_xor(rs, 2); rs += __shfl_xor(rs, 4); rs += __shfl_xor(rs, 8);
                    if (r16 == 0) DN[(dir * 2 + (wave & 1)) * 128 + row] = rs; }
            __syncthreads();
            const size_t tile = (size_t)u * 2 + dir;
            { bf16_t* dst = SG + tile * (CH * CH);
#pragma unroll
              for (int x = 0; x < 4; ++x) { const int idx = tid + x * NTH, row = idx >> 4, c16 = idx & 15; *(u32x4*)(dst + row * CH + c16 * 8) = *(const LAS u32x4*)(TS + row * LT + c16 * 8); } }
            if (tid < 128) { float* rg = RG + tile * 512; rg[tid] = AV[dir * 128 + tid]; rg[128 + tid] = PM[dir * 128 + tid]; rg[256 + tid] = BVS[dir * 128 + tid];
                rg[384 + tid] = DN[(dir * 2) * 128 + tid] + DN[(dir * 2 + 1) * 128 + tid]; }
            __syncthreads();
        }
    }
}
__device__ __forceinline__ void mlstm_scan(const Args& a, ldsp lds, int vcu, int G, int tid, int wave, int lane) {
    constexpr int SL = 64, NE = SL / 16, NT = SL / 32, NUNIT = 4 * 4 * 2 * (512 / SL);
    typedef short s16x4 __attribute__((ext_vector_type(4)));
    constexpr int LQ = 72, LT = 136, LC = 520;
    LAS float* WGT = (LAS float*)(lds + 0); LAS float* SCV = WGT + 128; LAS float* FTV = WGT + 256; LAS float* MT = WGT + 384; LAS float* DEN = WGT + 512; LAS float* NA = WGT + 640; LAS float* NBF = WGT + 1152; LAS float* NP = WGT + 1664; LAS float* QN = WGT + 2176;
    constexpr int QS0 = 11264, SETB = 35840, KTO = 18432;
    LAS bf16_t* VT = (LAS bf16_t*)(lds + QS0 + SETB);
    LAS bf16_t* CT = (LAS bf16_t*)(lds + QS0 + 2 * SETB);
    LAS bf16_t* NH = CT + SL * 520;
    static_assert(QS0 + 2 * SETB + SL * 1040 + 2048 <= LDS_XB && 128 * 144 == KTO && KTO + 64 * 272 == SETB && SL * 272 <= KTO, "LDS map of the mLSTM state phase");
    const int xb = lane >> 2, xi = lane & 3;
    for (int u = vcu; u < NUNIT; u += G) {
        const int js = u % (512 / SL), dir = (u / (512 / SL)) & 1, h = (u / (1024 / SL)) & 3, bl = u / (4096 / SL);
        f32x4 C[8][1][NT];
#pragma unroll
        for (int i = 0; i < 8; ++i)
#pragma unroll
            for (int tt = 0; tt < NT; ++tt) C[i][0][tt] = (f32x4){0.f, 0.f, 0.f, 0.f};
        for (int i = tid; i < (SL * 1040 + 2048) / 16; i += NTH) ((LAS u32x4*)CT)[i] = (u32x4){0u, 0u, 0u, 0u};
        NA[tid] = 0.f;
        float mprev = 0.f;
        __syncthreads();
        int ncur = 0;
        const int last = dir ? 0 : 127;
#pragma unroll 1
        for (int step = 0; step < NCH; ++step) {
            const int c = chunk_of_step(dir, step);
            const size_t rb = (size_t)bl * TB + (size_t)c * CH;
            const size_t tile = ((size_t)(bl * 4 + h) * NCH + c) * 2 + dir;
            const unsigned char* wsq; { const __attribute__((address_space(4))) Args* kq = (const __attribute__((address_space(4))) Args*)__builtin_amdgcn_kernarg_segment_ptr(); asm volatile("" : "+s"(kq)); wsq = kq->ws; }
            const bf16_t* XC = (const bf16_t*)(wsq + WS_BIG + SLOT); const bf16_t* V = (const bf16_t*)(wsq + WS_BIG + 2 * SLOT);
            bf16_t* HS = (bf16_t*)(wsq + WS_BIG + (dir ? 0 : 3 * SLOT));
            const bf16_t* SG = (const bf16_t*)(wsq + WS_Y) + (size_t)HT * DM; const float* RG = (const float*)(wsq + WS_DT);
            const bf16_t* WQT = (const bf16_t*)(wsq + WS_WQT); const bf16_t* WKT = (const bf16_t*)(wsq + WS_WKT);
            LAS float* Nold = ncur ? NBF : NA; LAS float* Nnew = ncur ? NA : NBF;
            const char* xcb = (const char*)(XC + rb * INNER + h * 512);
            const unsigned xoff = (unsigned)((16 * wave + xi) * INNER + 4 * xb) * 2u;
            const unsigned woff = (unsigned)((h * 128 + xb) * 16 + xi * 4) * 2u;
            u32x2 xg[4], wqf, wkf;
#pragma unroll
            for (int g = 0; g < 4; ++g) xg[g] = *(const u32x2*)(xcb + xoff + (unsigned)(4 * g * INNER * 2));
            wqf = *(const u32x2*)((const char*)WQT + woff); wkf = *(const u32x2*)((const char*)WKT + woff);
            int tp = tid; asm volatile("" : "+v"(tp));
            const float* rg = RG + tile * 512;
            const float bend = rg[256 + last], pmend = rg[128 + last];
            const float mnew = bend + fmaxf(mprev, pmend), dec = __expf(bend + mprev - mnew);
            {
              if (tp < 128) { const float ar = rg[tp], pmr = rg[128 + tp], br = rg[256 + tp];
                  WGT[tp] = __expf(bend + ar - mnew); SCV[tp] = __expf(fminf(0.f, mprev - pmr)); FTV[tp] = __expf(fminf(0.f, pmr - mprev)); MT[tp] = br + fmaxf(mprev, pmr); DEN[tp] = rg[384 + tp]; }
              {
                  const int rowv = tp >> 3, chv = tp & 7; const char* vq = (const char*)(V + rb * INNER + h * 512 + js * SL) + (unsigned)(rowv * INNER * 2 + chv * 16);
#pragma unroll
                  for (int x = 0; x < 2; ++x) { const u32x4 v0 = *(const u32x4*)(vq + (unsigned)(x * 64 * INNER * 2)); *(LAS u32x4*)((ldsp)VT + (64 * x + rowv) * 144 + chv * 16) = v0; } }
            }
#pragma unroll
            for (int i = 0; i < 8; ++i)
#pragma unroll
                for (int tt = 0; tt < NT; ++tt) C[i][0][tt] *= dec;
            f32x4 Iacc[2][2];
#pragma unroll
            for (int x = 0; x < 2; ++x)
#pragma unroll
                for (int y = 0; y < 2; ++y) Iacc[x][y] = (f32x4){0.f, 0.f, 0.f, 0.f};
            float qn[4] = {0.f, 0.f, 0.f, 0.f};
            const LAS bf16_t* NHold = NH + (ncur ? 512 : 0); LAS bf16_t* NHnew = NH + (ncur ? 0 : 512);
            __syncthreads();
            f32x4 wg4[4];
#pragma unroll
            for (int g = 0; g < 4; ++g) wg4[g] = *(const LAS f32x4*)(WGT + 16 * wave + 4 * g);
            bf16x8 vb[NT][4];
            {
                int tv = tid; asm volatile("" : "+v"(tv)); const int l16 = tv & 15, kqv = (tv >> 4) & 3;
                const ldsp vbp = (ldsp)VT + (8 * kqv + (l16 >> 2)) * 144 + ((SL / 2) * (wave & 1) + 4 * (l16 & 3)) * 2;
                typedef short v4i16_t __attribute__((ext_vector_type(4)));
#pragma unroll
                for (int tt = 0; tt < NT; ++tt)
#pragma unroll
                    for (int ks = 0; ks < 4; ++ks) {
                        const v4i16_t lo = __builtin_amdgcn_ds_read_tr16_b64_v4i16((LAS v4i16_t*)(vbp + (32 * ks) * 144 + 32 * tt));
                        const v4i16_t hi = __builtin_amdgcn_ds_read_tr16_b64_v4i16((LAS v4i16_t*)(vbp + (32 * ks + 4) * 144 + 32 * tt));
                        vb[tt][ks] = (bf16x8){lo[0], lo[1], lo[2], lo[3], hi[0], hi[1], hi[2], hi[3]}; } }
#define MK_STAGE(SI) { const int sb_ = (SI) & 1; LAS bf16_t* QSw = (LAS bf16_t*)(lds + QS0 + sb_ * SETB); LAS bf16_t* KTw = (LAS bf16_t*)(lds + QS0 + KTO + sb_ * SETB); \
                    const s16x4 wqa = __builtin_bit_cast(s16x4, wqf), wkb = __builtin_bit_cast(s16x4, wkf); \
                    const u32x2 nvp = *(const LAS u32x2*)(NHold + (SI) * 64 + 4 * xb); \
                    _Pragma("unroll") for (int g = 0; g < 4; ++g) { \
                        const s16x4 xf = __builtin_bit_cast(s16x4, xg[g]); const f32x4 z4 = {0.f, 0.f, 0.f, 0.f}; \
                        const f32x4 q = __builtin_amdgcn_mfma_f32_4x4x4bf16_1k(wqa, xf, z4, 0, 0, 0);       \
                        f32x4 k = __builtin_amdgcn_mfma_f32_4x4x4bf16_1k(xf, wkb, z4, 0, 0, 0);             \
                        k *= wg4[g]; \
                        u32x2 qp, kp; qp.x = pk_bf16(q[0], q[1]); qp.y = pk_bf16(q[2], q[3]); kp.x = pk_bf16(k[0], k[1]); kp.y = pk_bf16(k[2], k[3]); \
                        *(LAS u32x2*)(QSw + (16 * wave + 4 * g + xi) * LQ + 4 * xb) = qp; \
                        *(LAS u32x2*)(KTw + (4 * xb + xi) * LT + 16 * wave + 4 * g) = kp; \
                        asm("v_dot2c_f32_bf16 %0, %1, %2" : "+v"(qn[g]) : "v"(qp.x), "v"(nvp.x));     \
                        asm("v_dot2c_f32_bf16 %0, %1, %2" : "+v"(qn[g]) : "v"(qp.y), "v"(nvp.y)); \
                    } \
                    if ((SI) == 7) {                                                \
                        _Pragma("unroll") for (int g = 0; g < 4; ++g) { float v = qn[g]; v += __shfl_xor(v, 4); v += __shfl_xor(v, 8); v += __shfl_xor(v, 16); v += __shfl_xor(v, 32); if (xb == 0) QN[16 * wave + 4 * g + xi] = v; } \
                    } }
#define MK_PREFETCH(SI) { _Pragma("unroll") for (int g = 0; g < 4; ++g) xg[g] = *(const u32x2*)(xcb + (unsigned)((SI) * 128) + xoff + (unsigned)(4 * g * INNER * 2)); \
                    wqf = *(const u32x2*)((const char*)WQT + woff + (unsigned)((SI) * 512)); wkf = *(const u32x2*)((const char*)WKT + woff + (unsigned)((SI) * 512)); }
            MK_STAGE(0)
            MK_PREFETCH(1)
            __syncthreads();
            const bf16x8 onesf = __builtin_bit_cast(bf16x8, (lane & 15) == 0 ? (u32x4){0x3F803F80u, 0x3F803F80u, 0x3F803F80u, 0x3F803F80u} : (u32x4){0u, 0u, 0u, 0u});
            u32x4 sfa[4], sfb[4];
#pragma unroll
            for (int i = 0; i < 8; ++i) {
                if (i < 7) { MK_STAGE(i + 1) if (i < 6) MK_PREFETCH(i + 2) }
                else {
                    int tq = tid; asm volatile("" : "+v"(tq)); const char* src = (const char*)(SG + tile * (CH * CH)) + (unsigned)(((32 * (wave >> 1) + (tq & 15)) * CH + ((tq >> 4) & 3) * 8) * 2);
#pragma unroll
                    for (int ks = 0; ks < 4; ++ks) sfa[ks] = *(const u32x4*)(src + ks * 64); }
                const int cb = i & 1; const LAS bf16_t* QSr = (const LAS bf16_t*)(lds + QS0 + cb * SETB); const LAS bf16_t* KTr = (const LAS bf16_t*)(lds + QS0 + KTO + cb * SETB);
                wmma<2, 2, 2>(Iacc, CT + ((SL / 2) * (wave & 1)) * LC + i * 64, LC, QSr + (32 * (wave >> 1)) * LQ, LQ, lane);
                {
                    const LAS bf16_t* Ak = KTr + (16 * (wave >> 1) + (lane & 15)) * LT + (lane >> 4) * 8;
                    bf16x8 af[4];
#pragma unroll
                    for (int ks = 0; ks < 4; ++ks) af[ks] = *(const LAS bf16x8*)(Ak + ks * 32);
#define MK_UPD(ci) { _Pragma("unroll") for (int ks = 0; ks < 4; ++ks) _Pragma("unroll") for (int tt = 0; tt < NT; ++tt) C[ci][0][tt] = __builtin_amdgcn_mfma_f32_16x16x32_bf16(af[ks], vb[tt][ks], C[ci][0][tt], 0, 0, 0); }
                    MK_UPD(i)
#undef MK_UPD
                    const int ctile = wave >> 1;
                    if (wave == 2 * ctile + ((ctile ^ (ctile >> 1)) & 1)) {
                        f32x4 nacc = {0.f, 0.f, 0.f, 0.f};
#pragma unroll
                        for (int ks = 0; ks < 4; ++ks) nacc = __builtin_amdgcn_mfma_f32_16x16x32_bf16(af[ks], onesf, nacc, 0, 0, 0);
                        if ((lane & 15) == 0) { const int idx = i * 64 + 16 * ctile + 4 * (lane >> 4);
                            const f32x4 nn = dec * *(const LAS f32x4*)(Nold + idx) + nacc; *(LAS f32x4*)(Nnew + idx) = nn;
                            u32x2 w; w.x = pk_bf16(nn[0], nn[1]); w.y = pk_bf16(nn[2], nn[3]); *(LAS u32x2*)(NHnew + idx) = w; }
                    }
                }
                __syncthreads();
                __builtin_amdgcn_sched_barrier(0);
            }
#undef MK_STAGE
#undef MK_PREFETCH
            int te = tid; asm volatile("" : "+v"(te));
            const int r16e = te & 15, kqe = (te >> 4) & 3;
            { const char* src = (const char*)(SG + tile * (CH * CH)) + (unsigned)(((32 * (wave >> 1) + 16 + r16e) * CH + kqe * 8) * 2);
#pragma unroll
              for (int ks = 0; ks < 4; ++ks) sfb[ks] = *(const u32x4*)(src + ks * 64); }
            float fa[2], fb[2];
#pragma unroll
            for (int ni = 0; ni < 2; ++ni) { const int t = 32 * (wave >> 1) + 16 * ni + r16e; const float scv = SCV[t], ft = FTV[t];
                const float den = ft * DEN[t] + scv * QN[t]; const float inv = __builtin_amdgcn_rcpf(fmaxf(fabsf(den), __expf(-MT[t]))); fa[ni] = ft * inv; fb[ni] = scv * inv; }
#pragma unroll
            for (int i = 0; i < 8; ++i)
#pragma unroll
                for (int tt = 0; tt < NT; ++tt) { u32x2 w; w.x = pk_bf16(C[i][0][tt][0], C[i][0][tt][1]); w.y = pk_bf16(C[i][0][tt][2], C[i][0][tt][3]);
                    *(LAS u32x2*)(CT + ((SL / 2) * (wave & 1) + 16 * tt + r16e) * LC + 64 * i + 16 * (wave >> 1) + 4 * kqe) = w; }
#pragma unroll
            for (int ni = 0; ni < 2; ++ni) {
                const int t = 32 * (wave >> 1) + 16 * ni + r16e;
                f32x4 Nacc[2] = {(f32x4){0.f, 0.f, 0.f, 0.f}, (f32x4){0.f, 0.f, 0.f, 0.f}};
#pragma unroll
                for (int ks = 0; ks < 4; ++ks) { const bf16x8 bfr = __builtin_bit_cast(bf16x8, ni ? sfb[ks] : sfa[ks]);
#pragma unroll
                    for (int mi = 0; mi < 2; ++mi) Nacc[mi] = __builtin_amdgcn_mfma_f32_16x16x32_bf16(vb[mi][ks], bfr, Nacc[mi], 0, 0, 0); }
                bf16_t* op = (bf16_t*)((char*)(HS + rb * INNER + h * 512 + js * SL + (SL / 2) * (wave & 1)) + (unsigned)(t * INNER + 4 * kqe) * 2u);
#pragma unroll
                for (int mi = 0; mi < 2; ++mi) { float o[4];
#pragma unroll
                    for (int jj = 0; jj < 4; ++jj) o[jj] = fa[ni] * Nacc[mi][jj] + fb[ni] * Iacc[mi][ni][jj];
                    u32x2 w; w.x = pk_bf16(o[0], o[1]); w.y = pk_bf16(o[2], o[3]); *(u32x2*)(op + 16 * mi) = w; }
            }
            __syncthreads();
            mprev = mnew; ncur ^= 1;
        }
    }
}
__device__ __forceinline__ void mlstm_readout(const Args& a, int gw, int NGW, int lane) {
    const bf16_t* XC = (const bf16_t*)(a.ws + WS_BIG + SLOT); bf16_t* HSF = (bf16_t*)(a.ws + WS_BIG + 3 * SLOT); const bf16_t* HSB = (const bf16_t*)(a.ws + WS_BIG);
    const float* ng = a.in[18]; const float* sk = a.in[19];
    f32x4 G0[4], G1[4], K0[4], K1[4];
#pragma unroll
    for (int hh = 0; hh < 4; ++hh) { const int col = 512 * hh + 8 * lane; G0[hh] = *(const f32x4*)(ng + col); G1[hh] = *(const f32x4*)(ng + col + 4); K0[hh] = *(const f32x4*)(sk + col); K1[hh] = *(const f32x4*)(sk + col + 4); }
    for (int r = gw; r < HT; r += NGW) {
#pragma unroll
        for (int hh = 0; hh < 4; ++hh) { const size_t o = (size_t)r * INNER + 512 * hh + 8 * lane; const int col = 512 * hh + 8 * lane;
            float v[8], w[8], xc[8]; unpack8(*(const u32x4*)(HSF + o), v); unpack8(*(const u32x4*)(HSB + o), w); unpack8(*(const u32x4*)(XC + o), xc);
            float s = 0.f;
#pragma unroll
            for (int j = 0; j < 8; ++j) { v[j] += w[j]; s += v[j]; }
            const float mu = wave_sum(s) * (1.f / 512.f); float s2 = 0.f;
#pragma unroll
            for (int j = 0; j < 8; ++j) { v[j] -= mu; s2 += v[j] * v[j]; }
            const float rstd = rsqrtf(wave_sum(s2) * (1.f / 512.f) + EPS);
            const f32x4 g0 = G0[hh], g1 = G1[hh], k0 = K0[hh], k1 = K1[hh]; (void)col;
#pragma unroll
            for (int j = 0; j < 4; ++j) { v[j] = v[j] * rstd * g0[j] + k0[j] * xc[j]; v[4 + j] = v[4 + j] * rstd * g1[j] + k1[j] * xc[4 + j]; }
            *(u32x4*)(HSF + o) = pack8(v); }
    }
}

__device__ __forceinline__ void ssd_prep(const Args& a, int blk, int G, int tid) {
    const bf16_t* XP = (const bf16_t*)(a.ws + WS_BIG); bf16_t* XO = (bf16_t*)(a.ws + WS_BIG + 2 * SLOT);
    const float* conv_w = a.in[22]; const float* conv_b = a.in[23];
    const int ch = tid * 8;
    float cw[5][8], cb[8];
#pragma unroll
    for (int d = 0; d < 5; ++d) { const f32x4 w0 = *(const f32x4*)(conv_w + d * 4096 + ch), w1 = *(const f32x4*)(conv_w + d * 4096 + ch + 4);
#pragma unroll
        for (int c = 0; c < 4; ++c) { cw[d][c] = w0[c]; cw[d][4 + c] = w1[c]; } }
    { const f32x4 b0 = *(const f32x4*)(conv_b + ch), b1 = *(const f32x4*)(conv_b + ch + 4);
#pragma unroll
      for (int c = 0; c < 4; ++c) { cb[c] = b0[c]; cb[4 + c] = b1[c]; } }
    for (int u = blk; u < HT / 16; u += G) {
        const int r0 = u * 16, t0 = r0 % TB; int slo, shi; conv_seg(t0, slo, shi);
        float win[5][8];
#pragma unroll
        for (int d = 0; d < 4; ++d) { const int t = t0 - 2 + d; u32x4 w = {0u, 0u, 0u, 0u}; if (t >= slo && t < shi) w = *(const u32x4*)(XP + (size_t)(r0 - 2 + d) * 4096 + ch); unpack8(w, win[d]); }
        u32x4 nxt[16];
#pragma unroll
        for (int tt = 0; tt < 16; ++tt) { const int t = t0 + tt + 2; nxt[tt] = (u32x4){0u, 0u, 0u, 0u}; if (t >= slo && t < shi) nxt[tt] = *(const u32x4*)(XP + (size_t)(r0 + tt + 2) * 4096 + ch); }
#pragma unroll
        for (int hb = 0; hb < 2; ++hb) {
            u32x4 ob[8];
#pragma unroll
            for (int t8 = 0; t8 < 8; ++t8) { const int tt = hb * 8 + t8;
                unpack8(nxt[tt], win[4]);
                float o[8];
#pragma unroll
                for (int c = 0; c < 8; ++c) { float sacc = cb[c];
#pragma unroll
                    for (int d = 0; d < 5; ++d) sacc += cw[d][c] * win[d][c];
                    o[c] = silu_f(sacc); }
                ob[t8] = pack8(o);
#pragma unroll
                for (int d = 0; d < 4; ++d)
#pragma unroll
                    for (int c = 0; c < 8; ++c) win[d][c] = win[d + 1][c];
            }
#pragma unroll
            for (int t8 = 0; t8 < 8; ++t8) *(u32x4*)(XO + (size_t)(r0 + hb * 8 + t8) * 4096 + ch) = ob[t8];
        }
    }
}
__device__ __forceinline__ void ssd_scan(const Args& a, ldsp lds, int vcu, int G, int tid, int wave, int lane) {
    const bf16_t* X = (const bf16_t*)(a.ws + WS_BIG + 2 * SLOT); bf16_t* YF = (bf16_t*)(a.ws + WS_BIG); bf16_t* YB = (bf16_t*)(a.ws + WS_BIG + SLOT);
    const float* DT = (const float*)(a.ws + WS_DT);
    constexpr int LT = 136;
    LAS bf16_t* CM = (LAS bf16_t*)(lds + 4096); LAS bf16_t* BM = (LAS bf16_t*)(lds + 38912); LAS bf16_t* BT = (LAS bf16_t*)(lds + 73728); LAS bf16_t* XT = (LAS bf16_t*)(lds + 108544); LAS bf16_t* HB = (LAS bf16_t*)(lds + 125952);
    LAS float* DTV = (LAS float*)(lds + 0); LAS float* CS = DTV + 128; LAS float* ECS = DTV + 256; LAS float* WG = DTV + 384; LAS float* SCAL = DTV + 512;
    const int r16 = lane & 15, kq = lane >> 4;
    typedef short s16x4 __attribute__((ext_vector_type(4)));
    const int xb = lane >> 2, xi = lane & 3;
    const s16x4 idf = {(short)(xi == 0 ? 0x3F80 : 0), (short)(xi == 1 ? 0x3F80 : 0), (short)(xi == 2 ? 0x3F80 : 0), (short)(xi == 3 ? 0x3F80 : 0)};
    for (int u = vcu; u < 256; u += G) {
        const int hr = u & 3, dir = (u >> 2) & 1, g = (u >> 3) & 7, bl = u >> 6, head = g * 4 + hr;
        bf16_t* Y = dir ? YB : YF;
        const float a_neg = -__expf(a.in[25][dir * 32 + head]), dtb = a.in[24][dir * 32 + head], dsk = dir ? 0.f : a.in[26][head];
        f32x4 Hs[1][4];
#pragma unroll
        for (int x = 0; x < 4; ++x) Hs[0][x] = (f32x4){0.f, 0.f, 0.f, 0.f};
        for (int i = tid; i < 17408 / 16; i += NTH) ((LAS u32x4*)HB)[i] = (u32x4){0u, 0u, 0u, 0u};
        u32x4 cmr[4], bmq[4]; u32x2 xgr[4]; float dtn = 0.f;
#define SSD_LOADS(step_) { const size_t rb_ = (size_t)bl * TB + (size_t)chunk_of_step(dir, step_) * CH; int tq = tid; asm volatile("" : "+v"(tq)); \
            const bf16_t* xr_ = X + (rb_ + 16 * wave + ((tq & 63) >> 4)) * 4096 + 3072 + g * 128 + (tq & 15) * 8;     \
            _Pragma("unroll") for (int x = 0; x < 4; ++x) cmr[x] = *(const u32x4*)(xr_ + (size_t)(4 * x) * 4096); \
            const bf16_t* xq_ = X + (rb_ + 16 * wave + (tq & 3)) * 4096 + 4 * ((tq & 63) >> 2); \
            _Pragma("unroll") for (int gq = 0; gq < 4; ++gq) { bmq[gq] = *(const u32x4*)(xq_ + 4 * ((tq & 63) >> 2) + gq * 4 * 4096 + 2048 + g * 128); \
                xgr[gq] = *(const u32x2*)(xq_ + gq * 4 * 4096 + head * 64); } \
            if (tq < 128) dtn = DT[(rb_ + tq) * 64 + dir * 32 + head]; }
        SSD_LOADS(0)
        __syncthreads();
#pragma unroll 1
        for (int step = 0; step < NCH; ++step) {
            const int c = chunk_of_step(dir, step);
            const size_t rb = (size_t)bl * TB + (size_t)c * CH;
            const bool need_y = c >= 2;
            int tp = tid; asm volatile("" : "+v"(tp));
            const int srow = tp & 127, cq = wave >> 1;
            const f32x4 z4 = {0.f, 0.f, 0.f, 0.f};
            if (tp < 128) { const float dt = softplus_f(dtn + dtb); DTV[tp] = dt; CS[tp] = dt * a_neg; }
            {
#pragma unroll
              for (int x = 0; x < 4; ++x) *(LAS u32x4*)(CM + (16 * wave + 4 * x + ((tp & 63) >> 4)) * LT + (tp & 15) * 8) = cmr[x];
#pragma unroll
              for (int gq = 0; gq < 4; ++gq) { const int t0 = 16 * wave + 4 * gq;
                  *(LAS u32x4*)(BM + (t0 + xi) * LT + 8 * xb) = bmq[gq];
                  { const f32x4 d = __builtin_amdgcn_mfma_f32_4x4x4bf16_1k(__builtin_bit_cast(s16x4, xgr[gq]), idf, z4, 0, 0, 0);
                    u32x2 w; w.x = pk_bf16(d[0], d[1]); w.y = pk_bf16(d[2], d[3]); *(LAS u32x2*)(XT + (4 * xb + xi) * LT + t0) = w; } }
            }
            __syncthreads();
            if (wave == 0) {
                const int p0 = 2 * lane, p1 = 2 * lane + 1, n0 = dir ? 127 - p0 : p0, n1 = dir ? 127 - p1 : p1;
                const float l0 = CS[n0], l1 = CS[n1];
                const float S = wscan_add(l0 + l1, lane), c1 = S, c0 = S - l1, cend = __builtin_bit_cast(float, __builtin_amdgcn_readlane(__builtin_bit_cast(int, S), 63));
                CS[n0] = c0 * 1.44269504f; CS[n1] = c1 * 1.44269504f; ECS[n0] = __expf(c0); ECS[n1] = __expf(c1);
                WG[n0] = __expf(cend - c0) * DTV[n0]; WG[n1] = __expf(cend - c1) * DTV[n1];
                if (lane == 0) SCAL[0] = __expf(cend);
            }
            f32x4 CB[2][4], Iacc[4][1];
#pragma unroll
            for (int x = 0; x < 2; ++x)
#pragma unroll
                for (int y = 0; y < 4; ++y) CB[x][y] = (f32x4){0.f, 0.f, 0.f, 0.f};
#pragma unroll
            for (int x = 0; x < 4; ++x) Iacc[x][0] = (f32x4){0.f, 0.f, 0.f, 0.f};
            if (need_y) wmma<2, 4, 4>(CB, BM + (32 * (wave >> 1)) * LT, LT, CM + (64 * (wave & 1)) * LT, LT, lane);
            if (need_y) wmma<4, 1, 4>(Iacc, HB, LT, CM + (16 * wave) * LT, LT, lane);
            __syncthreads();
            {
#pragma unroll
              for (int gq = 0; gq < 4; ++gq) { const int t0 = 16 * wave + 4 * gq; const f32x4 wg4 = *(const LAS f32x4*)(WG + t0);
#pragma unroll
                  for (int ch = 0; ch < 2; ++ch) {
                      const u32x2 bh = ch ? (u32x2){bmq[gq].z, bmq[gq].w} : (u32x2){bmq[gq].x, bmq[gq].y};
                      f32x4 d = __builtin_amdgcn_mfma_f32_4x4x4bf16_1k(__builtin_bit_cast(s16x4, bh), idf, z4, 0, 0, 0);
                      d *= wg4; u32x2 w; w.x = pk_bf16(d[0], d[1]); w.y = pk_bf16(d[2], d[3]); *(LAS u32x2*)(BT + (8 * xb + 4 * ch + xi) * LT + t0) = w; } }
            }
            LAS bf16_t* MM = CM;
            const int dls = (dir ? -1 : 1) * (64 * (wave & 1) + r16 - 32 * (wave >> 1) - 4 * kq), sgi = dir ? -1 : 1;
            if (need_y) {
            float cst[4];
#pragma unroll
            for (int ni = 0; ni < 4; ++ni) cst[ni] = CS[64 * (wave & 1) + 16 * ni + r16];
#pragma unroll
            for (int mi = 0; mi < 2; ++mi) { const int s0 = 32 * (wave >> 1) + 16 * mi + 4 * kq; const f32x4 css = *(const LAS f32x4*)(CS + s0), dts = *(const LAS f32x4*)(DTV + s0);
#pragma unroll
                for (int ni = 0; ni < 4; ++ni) { const int t = 64 * (wave & 1) + 16 * ni + r16; float e[4];
#pragma unroll
                    for (int jj = 0; jj < 4; ++jj) { const float v = CB[mi][ni][jj] * __builtin_amdgcn_exp2f(fminf(cst[ni] - css[jj], 0.f)) * dts[jj];
                        e[jj] = (dls + sgi * (16 * ni - 16 * mi - jj) >= 0) ? v : 0.f; }
                    u32x2 w; w.x = pk_bf16(e[0], e[1]); w.y = pk_bf16(e[2], e[3]); *(LAS u32x2*)(MM + t * LT + s0) = w; } }
            }
            if (step + 1 < NCH) SSD_LOADS(step + 1)
            __syncthreads();
            f32x4 Yacc[4][1];
#pragma unroll
            for (int x = 0; x < 4; ++x) Yacc[x][0] = (f32x4){0.f, 0.f, 0.f, 0.f};
            if (need_y) {
            wmma<4, 1, 4>(Yacc, XT, LT, MM + (16 * wave) * LT, LT, lane);
            { const int t = 16 * wave + r16; const float ecs = ECS[t]; bf16_t* op = Y + (rb + t) * INNER + head * 64 + 4 * kq;
#pragma unroll
              for (int mi = 0; mi < 4; ++mi) { float o[4];
#pragma unroll
                  for (int jj = 0; jj < 4; ++jj) o[jj] = Yacc[mi][0][jj] + ecs * Iacc[mi][0][jj] + dsk * bf1(XT[(16 * mi + 4 * kq + jj) * LT + t]);
                  u32x2 w; w.x = cvt_pk_bf16(o[0], o[1]); w.y = cvt_pk_bf16(o[2], o[3]); *(u32x2*)(op + 16 * mi) = w; } }
            }
            const float dec = SCAL[0];
#pragma unroll
            for (int x = 0; x < 4; ++x) Hs[0][x] *= dec;
            wmma<1, 4, 4>(Hs, BT + (16 * wave) * LT, LT, XT, LT, lane);
#pragma unroll
            for (int ni = 0; ni < 4; ++ni) { u32x2 w; w.x = pk_bf16(Hs[0][ni][0], Hs[0][ni][1]); w.y = pk_bf16(Hs[0][ni][2], Hs[0][ni][3]);
                *(LAS u32x2*)(HB + (16 * ni + r16) * LT + 16 * wave + 4 * kq) = w; }
            __syncthreads();
        }
#undef SSD_LOADS
    }
}

typedef const __attribute__((address_space(4))) Args* KArgsPtr;
__global__ void __launch_bounds__(NTH, 2) fwd(Args a_unused) {
    extern __shared__ __attribute__((aligned(16))) unsigned char lds_raw[];
    const ldsp lds = (ldsp)lds_raw;
    const int G = gridDim.x;
    if (threadIdx.x == 0) *(LAS u32x4*)(lds + LDS_XB) = (u32x4){0u, 0u, blockIdx.x, 0u};
    __syncthreads();
    (void)xcd_barrier_post((unsigned*)(a_unused.ws + WS_CTL), (volatile LAS unsigned*)(lds + LDS_XB));
    const int NGW = G * NWAVES;
    int lblk = blockIdx.x;
#define IDS int tid_ = threadIdx.x, blk_ = lblk; KArgsPtr kp_ = (KArgsPtr)__builtin_amdgcn_kernarg_segment_ptr(); asm volatile("" : "+v"(tid_), "+s"(blk_), "+s"(kp_)); \
    const Args& a = *(const Args*)kp_; unsigned char* const ws = a.ws; \
    const int lane_ = tid_ & 63, wave_ = __builtin_amdgcn_readfirstlane(tid_ >> 6), gw_ = blk_ * NWAVES + wave_, vcu_ = (G % 8 == 0) ? (blk_ % 8) * (G / 8) + blk_ / 8 : blk_; \
    bf16_t* const W = (bf16_t*)(ws + WS_W); bf16_t* const Hb = (bf16_t*)(ws + WS_H); bf16_t* const Yb = (bf16_t*)(ws + WS_Y); bf16_t* const BIG = (bf16_t*)(ws + WS_BIG); \
    float* const ctxs = (float*)(ws + WS_CTXS); const float* const mod = (const float*)(ws + WS_MOD); \
    (void)lane_; (void)wave_; (void)gw_; (void)vcu_; (void)W; (void)Hb; (void)Yb; (void)BIG; (void)ctxs; (void)mod;
#define PH_END do { KArgsPtr kq_ = (KArgsPtr)__builtin_amdgcn_kernarg_segment_ptr(); asm volatile("" : "+s"(kq_)); XcdBarrier b_; b_.bar = (unsigned*)(((const Args*)kq_)->ws + WS_CTL); \
        b_.x = xb_xcc_id(); b_.st = (volatile LAS unsigned*)(lds + LDS_XB); xcd_barrier(b_); } while (0)

    { IDS convert_layer(a, 0, lds, gw_, NGW, wave_, lane_); __syncthreads(); mods_phase(a, lds, blk_, G, tid_); } PH_END;
    if (threadIdx.x == 0) { const __attribute__((address_space(4))) Args* kq0 = (const __attribute__((address_space(4))) Args*)__builtin_amdgcn_kernarg_segment_ptr(); asm volatile("" : "+s"(kq0));
        unsigned* bar = (unsigned*)(kq0->ws + WS_CTL); bool ok = (G % 8) == 0;
        for (unsigned j = 0; j < 16; ++j) { const unsigned c = xb_ld(&bar[XB_XCNT(j)]); ok = ok && (j < 8 ? c == (unsigned)(G / 8) : c == 0u); }
        if (ok) { const unsigned xcc = xb_xcc_id(); const unsigned r = xb_add(bar + 8192 + xcc, 1u); *(volatile LAS unsigned*)(lds + LDS_XB + 8) = r * 8u + xcc; } }
    __syncthreads();
    lblk = __builtin_amdgcn_readfirstlane(*(volatile LAS int*)(lds + LDS_XB + 8));
    { IDS rows_phase(a.in[0], a.in[2], nullptr, nullptr, nullptr, nullptr, nullptr, nullptr, 0, 0.f, Hb, a.in[6], mod, 0, 0, 0, NB, 0, 0, blk_, G, wave_, lane_); } PH_END;

#pragma unroll 1
    for (int layer = 0; layer < 2; ++layer) {
        const bool last = layer == 1;
#pragma unroll 1
        for (int sub = 0; sub < 2; ++sub) {
            const bool lat_only = last && sub == 1;
            { IDS pg8::Gemm g{Hb, W + (sub ? WO_GU2 : WO_GU1), T, 2 * DFF, DM}; EpiSwiglu E{BIG, DFF};
                if (lat_only) { LatentOrder S; S.init(NB * SEQ, 2 * DFF, G, blk_); pg8::gemm_phase<EpiSwiglu, LatentOrder, false>(lds, g, S, E, nullptr); }
                else { pg8::StaticOrder S; S.init(T, 2 * DFF, G, blk_); pg8::gemm_phase<EpiSwiglu, pg8::StaticOrder, false>(lds, g, S, E, nullptr); } } PH_END;
            { IDS pg8::Gemm g{BIG, W + (sub ? WO_D2 : WO_D1), T, DM, DFF}; pg8::EpiBf16<0> E{Yb, DM, nullptr, 0, 0};
                LatentOrder S; S.init(NB * SEQ, DM, G, blk_); pg8::gemm_phase<pg8::EpiBf16<0>, LatentOrder, false>(lds, g, S, E, nullptr); } PH_END;
            constexpr int NCTXWG = 32;
#define DOWN_CTX() { pg8::Gemm g{BIG, W + (sub ? WO_D2 : WO_D1), T, DM, DFF}; pg8::EpiBf16<0> E{Yb, DM, nullptr, 0, 0}; CtxOrder S; S.init(NB, DM / 256, blk_); \
                     pg8::gemm_phase<pg8::EpiBf16<0>, CtxOrder, false>(lds, g, S, E, nullptr); }
            if (sub == 0) {
#define ROWS1(mode_, blk__, G__) rows_phase(layer == 0 ? a.in[0] : a.out, layer == 0 ? a.in[2] : ctxs, a.out, ctxs, Yb, nullptr, gl + 1 * DM, modl, 2, 0.5f, Hb, gl + 2 * DM, modl, 3, mode_, 0, NB, layer != 0, 1, blk__, G__, wave_, lane_)
                { IDS const float* gl = a.in[6] + (size_t)layer * 6 * DM; const float* modl = mod + (size_t)layer * 9 * 9216;
                    if (blk_ < NCTXWG) DOWN_CTX() else ROWS1(1, blk_ - NCTXWG, G - NCTXWG); } PH_END;
                { IDS const float* gl = a.in[6] + (size_t)layer * 6 * DM; const float* modl = mod + (size_t)layer * 9 * 9216; ROWS1(2, blk_, G); } PH_END;
#undef ROWS1
                if (layer == 0) {
#pragma unroll 1
                    for (int half = 0; half < 2; ++half) {
                        { IDS pg8::Gemm g{Hb + (size_t)half * HT * DM, W + WO_IN, HT, INNER, DM}; pg8::StaticOrder S; S.init(HT, INNER, G, blk_); pg8::EpiBf16<0> E{BIG, INNER, nullptr, 0, 0};
                            pg8::gemm_phase<pg8::EpiBf16<0>, pg8::StaticOrder, false>(lds, g, S, E, nullptr); } PH_END;
                        { IDS mlstm_prep(a, lds, blk_, G, tid_, wave_, lane_); } PH_END;
                        { IDS mlstm_scores(a, lds, vcu_, G, tid_, wave_, lane_); } PH_END;
                        { IDS mlstm_scan(a, lds, vcu_, G, tid_, wave_, lane_); } PH_END;
                        { IDS mlstm_readout(a, gw_, NGW, lane_); } PH_END;
                        { IDS pg8::Gemm g{Hb + (size_t)half * HT * DM, W + WO_IN + (size_t)INNER * DM, HT, INNER, DM}; pg8::StaticOrder S; S.init(HT, INNER, G, blk_);
                            EpiMulSilu<false> E{(bf16_t*)(ws + WS_BIG + 3 * SLOT), nullptr, INNER, nullptr}; pg8::gemm_phase<EpiMulSilu<false>, pg8::StaticOrder, false>(lds, g, S, E, nullptr); } PH_END;
                        { IDS pg8::Gemm g{(const bf16_t*)(ws + WS_BIG + 3 * SLOT), W + WO_OUT, HT, DM, INNER}; LatentOrder S; S.init(HT / 17 * 16, DM, G, blk_);
                            pg8::EpiBf16<0> E{Yb + (size_t)half * HT * DM, DM, nullptr, 0, 0}; pg8::gemm_phase<pg8::EpiBf16<0>, LatentOrder, false>(lds, g, S, E, nullptr); } PH_END;
                        { IDS const float* gl = a.in[6] + (size_t)layer * 6 * DM; const float* modl = mod + (size_t)layer * 9 * 9216;
                            if (blk_ < 16) { pg8::Gemm g{(const bf16_t*)(ws + WS_BIG + 3 * SLOT), W + WO_OUT, HT, DM, INNER}; CtxOrder S; S.init(4, DM / 256, blk_);
                                pg8::EpiBf16<0> E{Yb + (size_t)half * HT * DM, DM, nullptr, 0, 0}; pg8::gemm_phase<pg8::EpiBf16<0>, CtxOrder, false>(lds, g, S, E, nullptr); }
                            else rows_phase(a.out, ctxs, a.out, ctxs, Yb, nullptr, gl + 3 * DM, modl, 5, 1.0f, Hb, gl + 4 * DM, modl, 6, 1, 4 * half, 4 * half + 4, 1, 1, blk_ - 16, G - 16, wave_, lane_); } PH_END;
                    }
                } else {
#pragma unroll 1
                    for (int half = 0; half < 2; ++half) {
                        { IDS pg8::Gemm g{Hb + (size_t)half * HT * DM, W + WO_IN + (size_t)INNER * DM, HT, 4352, DM}; pg8::StaticOrder S; S.init(HT, 4352, G, blk_); EpiSsdIn E{BIG, (float*)(ws + WS_DT)};
                            pg8::gemm_phase<EpiSsdIn, pg8::StaticOrder, false>(lds, g, S, E, nullptr); } PH_END;
                        { IDS ssd_prep(a, blk_, G, tid_); } PH_END;
                        { IDS ssd_scan(a, lds, vcu_, G, tid_, wave_, lane_); } PH_END;
                        { IDS pg8::Gemm g{Hb + (size_t)half * HT * DM, W + WO_IN, HT, INNER, DM}; LatentOrder S; S.init(HT / 17 * 16, INNER, G, blk_);
                            EpiMulSilu<true> E{BIG, (const bf16_t*)(ws + WS_BIG + SLOT), INNER, (float*)(ws + WS_SSQ) + (size_t)half * HT * 32}; pg8::gemm_phase<EpiMulSilu<true>, LatentOrder, false>(lds, g, S, E, nullptr); } PH_END;
                        { IDS pg8::Gemm g{BIG, W + WO_OUT, HT, DM, INNER}; LatentOrder S; S.init(HT / 17 * 16, DM, G, blk_);
                            pg8::EpiBf16<0> E{Yb + (size_t)half * HT * DM, DM, nullptr, 0, 0}; pg8::gemm_phase<pg8::EpiBf16<0>, LatentOrder, false>(lds, g, S, E, nullptr); } PH_END;
                    }
                }
                { IDS const float* gl = a.in[6] + (size_t)layer * 6 * DM; const float* modl = mod + (size_t)layer * 9 * 9216;
                    rows_phase(a.out, ctxs, a.out, ctxs, Yb, last ? (const float*)(ws + WS_SSQ) : nullptr, gl + 3 * DM, modl, 5, 1.0f, Hb, gl + 4 * DM, modl, 6, last ? 1 : 2, 0, NB, 1, 1, blk_, G, wave_, lane_); } PH_END;
            } else {
#define ROWS3(mode_, blk__, G__) rows_phase(a.out, ctxs, a.out, ctxs, Yb, nullptr, gl + 5 * DM, modl, 8, 0.5f, last ? nullptr : Hb, gl + 6 * DM, modl + 9 * 9216, 0, mode_, 0, NB, 1, last ? 0 : 1, blk__, G__, wave_, lane_)
                if (last) { IDS const float* gl = a.in[6] + (size_t)layer * 6 * DM; const float* modl = mod + (size_t)layer * 9 * 9216; ROWS3(1, blk_, G); }
                else {
                    { IDS const float* gl = a.in[6] + (size_t)layer * 6 * DM; const float* modl = mod + (size_t)layer * 9 * 9216;
                        if (blk_ < NCTXWG) DOWN_CTX() else ROWS3(1, blk_ - NCTXWG, G - NCTXWG); } PH_END;
                    { IDS const float* gl = a.in[6] + (size_t)layer * 6 * DM; const float* modl = mod + (size_t)layer * 9 * 9216; ROWS3(2, blk_, G);
                        __syncthreads(); convert_layer(a, 1, lds, gw_, NGW, wave_, lane_); } PH_END;
                }
#undef ROWS3
            }
        }
    }
#undef DOWN_CTX
#undef PH_END
#undef IDS
}
}

extern "C" void kernel_launch(void* const* d_in, const int* in_sizes, int n_in, void* d_out, int out_size, void* d_ws, size_t ws_size, hipStream_t stream) {
    static int grid = 0;
    if (grid == 0) {
        if (n_in != 29 || out_size != mk::NB * mk::SEQ * mk::DM || ws_size < mk::WS_END) {
            fprintf(stderr, "kernel_launch: unexpected problem (n_in %d, out %d, ws %zu, need %zu); nothing launched\n", n_in, out_size, ws_size, (size_t)mk::WS_END); grid = -1; return; }
        int dev = 0, cus = 0, per_cu = 0;
        if (hipGetDevice(&dev) != hipSuccess || hipDeviceGetAttribute(&cus, hipDeviceAttributeMultiprocessorCount, dev) != hipSuccess) { grid = -1; return; }
        if (hipFuncSetAttribute((const void*)mk::fwd, hipFuncAttributeMaxDynamicSharedMemorySize, mk::LDS_BYTES) != hipSuccess) { fprintf(stderr, "kernel_launch: hipFuncSetAttribute failed\n"); grid = -1; return; }
        if (hipOccupancyMaxActiveBlocksPerMultiprocessor(&per_cu, (const void*)mk::fwd, mk::NTH, mk::LDS_BYTES) != hipSuccess || per_cu < 1) {
            fprintf(stderr, "kernel_launch: occupancy query reports %d workgroups per CU; nothing launched\n", per_cu); (void)hipGetLastError(); grid = -1; return; }
        grid = cus;
    }
    if (grid < 0) return;
    if (hipMemsetAsync((char*)d_ws + mk::WS_CTL, 0, mk::CTL_ZERO_BYTES, stream) != hipSuccess) return;
    mk::Args a{};
    for (int i = 0; i < 29; ++i) a.in[i] = (const float*)d_in[i];
    a.out = (float*)d_out; a.ws = (unsigned char*)d_ws; a.ph_lo = 0; a.ph_hi = 0;
    hipLaunchKernelGGL(mk::fwd, dim3(grid), dim3(mk::NTH), mk::LDS_BYTES, stream, a);
}
```
